# Optimizing an MI355X kernel written in HIP

```python
import math
import jax, jax.numpy as jnp
from jax import lax
import numpy as np

D_MODEL = 2048
BATCH = 4
SEQ = 8192
DEPTH = 1

CHUNK = 64
Q_BLOCK = 128
ATT_HEADS = 8
ATT_HEAD_DIM = 64
ATT_V_DIM = 2 * ATT_HEAD_DIM
ATT_WIDTH = ATT_HEADS * ATT_V_DIM
SSM_HEADS = 16
SSM_HEAD_DIM = 64
SSM_WIDTH = SSM_HEADS * SSM_HEAD_DIM
SSM_GROUPS = 2
SSM_STATE = 128
SSM_CONV = 4
MIX_WIDTH = ATT_WIDTH + SSM_WIDTH
N_Q = ATT_HEADS * 2 * ATT_HEAD_DIM
N_K = ATT_HEADS * 2 * ATT_HEAD_DIM
N_V = ATT_HEADS * ATT_V_DIM
N_Z = SSM_WIDTH
N_XBC = SSM_WIDTH + 2 * SSM_GROUPS * SSM_STATE
N_DT = SSM_HEADS
IN_COLS = N_Q + N_K + N_V + N_Z + N_XBC + N_DT
N_EXPERT_GROUPS = 4
EXPERTS_PER_GROUP = 8
N_EXPERTS = N_EXPERT_GROUPS * EXPERTS_PER_GROUP
TOP_K = 2
EXPERT_HIDDEN = D_MODEL // 2
MOE_BLOCK = 256
DN_ALPHA = (2 * DEPTH) ** 0.25
DN_BETA = (8 * DEPTH) ** -0.25
LN_EPS = 1e-5
RMS_EPS = 1e-6

kernel_name = "hybrid_diffattn_ssd_hmoe_deepnorm"


def layer_norm(x, g, b):
    xf = x.astype(jnp.float32)
    mu = jnp.mean(xf, -1, keepdims=True)
    var = jnp.mean(jnp.square(xf - mu), -1, keepdims=True)
    return ((xf - mu) * lax.rsqrt(var + LN_EPS) * g + b).astype(x.dtype)


def rms_norm(x, g):
    xf = x.astype(jnp.float32)
    return (xf * lax.rsqrt(jnp.mean(xf * xf, -1, keepdims=True) + RMS_EPS) * g).astype(x.dtype)


def alibi_slopes(n):
    return jnp.exp2(-8.0 * jnp.arange(1, n + 1, dtype=jnp.float32) / n)


def diff_attention(q, k, v, lam, lambda_init, norm_w):
    Bsz, S = q.shape[0], q.shape[1]
    scale = ATT_HEAD_DIM ** -0.5
    slopes = alibi_slopes(ATT_HEADS)
    outs = []
    for qs in range(0, S, Q_BLOCK):
        ke = qs + Q_BLOCK
        s = jnp.einsum('bqhmd,bkhmd->bhmqk', q[:, qs:ke], k[:, :ke],
                       preferred_element_type=jnp.float32) * scale
        t = jnp.arange(qs, ke)
        sp = jnp.arange(ke)
        dist = jnp.abs(t[:, None] - sp[None, :]).astype(jnp.float32)
        allowed = (sp[None, :] // CHUNK) <= (t[:, None] // CHUNK)
        bias = jnp.where(allowed[None], -slopes[:, None, None] * dist[None], -jnp.inf)
        p = jax.nn.softmax(s + bias[None, :, None], axis=-1)
        w = p[:, :, 0] - lam * p[:, :, 1]
        outs.append(jnp.einsum('bhqk,bkhv->bqhv', w.astype(v.dtype), v[:, :ke]))
    o = jnp.concatenate(outs, axis=1)
    o = rms_norm(o, norm_w) * (1.0 - lambda_init)
    return o.reshape(Bsz, S, ATT_WIDTH)


def ssd_mixer(z, xbc, dt_raw, conv_w, conv_b, dt_bias, a_log, d_skip, norm_w):
    Bsz, S, _ = xbc.shape
    f32 = jnp.float32
    xbc = lax.conv_general_dilated(xbc, conv_w[:, None, :].astype(xbc.dtype), window_strides=(1,),
                                   padding=[(SSM_CONV - 1, 0)],
                                   dimension_numbers=('NWC', 'WIO', 'NWC'),
                                   feature_group_count=N_XBC) + conv_b
    xbc = jax.nn.silu(xbc)
    xs, bm, cm = jnp.split(xbc, [SSM_WIDTH, SSM_WIDTH + SSM_GROUPS * SSM_STATE], axis=-1)
    nc = S // CHUNK
    hpg = SSM_HEADS // SSM_GROUPS
    xs = xs.astype(f32).reshape(Bsz, nc, CHUNK, SSM_GROUPS, hpg, SSM_HEAD_DIM)
    bm = bm.astype(f32).reshape(Bsz, nc, CHUNK, SSM_GROUPS, SSM_STATE)
    cm = cm.astype(f32).reshape(Bsz, nc, CHUNK, SSM_GROUPS, SSM_STATE)
    dt = jax.nn.softplus(dt_raw.astype(f32) + dt_bias.astype(f32)).reshape(Bsz, nc, CHUNK, SSM_GROUPS, hpg)
    a_head = -jnp.exp(a_log.astype(f32)).reshape(SSM_GROUPS, hpg)
    acs = jnp.cumsum(jnp.moveaxis(dt * a_head, 2, -1), axis=-1)
    xdt = xs * dt[..., None]
    tril = jnp.tril(jnp.ones((CHUNK, CHUNK), dtype=bool))
    seg = acs[..., :, None] - acs[..., None, :]
    decay_ls = jnp.exp(jnp.where(tril, seg, -jnp.inf))
    cb = jnp.einsum('bclgn,bcsgn->bcgls', cm, bm)
    m = cb[:, :, :, None] * decay_ls
    y_diag = jnp.einsum('bcgels,bcsgep->bclgep', m, xdt)
    decay_states = jnp.moveaxis(jnp.exp(acs[..., -1:] - acs), -1, 2)
    states = jnp.einsum('bclgn,bclgep->bcgepn', bm, xdt * decay_states[..., None])
    chunk_decay = jnp.exp(acs[..., -1])

    def step(h, inp):
        st, dec = inp
        return h * dec[..., None, None] + st, h

    h0 = jnp.zeros((Bsz, SSM_GROUPS, hpg, SSM_HEAD_DIM, SSM_STATE), f32)
    _, prev = lax.scan(step, h0, (jnp.moveaxis(states, 1, 0), jnp.moveaxis(chunk_decay, 1, 0)))
    prev = jnp.moveaxis(prev, 0, 1)
    out_decay = jnp.moveaxis(jnp.exp(acs), -1, 2)
    y_off = jnp.einsum('bclgn,bcgepn->bclgep', cm, prev) * out_decay[..., None]
    y = y_diag + y_off + xs * d_skip.astype(f32).reshape(SSM_GROUPS, hpg)[..., None]
    y = y.reshape(Bsz, S, SSM_WIDTH) * jax.nn.silu(z.astype(f32))
    gsz = SSM_WIDTH // SSM_GROUPS
    y = y.reshape(Bsz, S, SSM_GROUPS, gsz)
    y = y * lax.rsqrt(jnp.mean(y * y, -1, keepdims=True) + RMS_EPS)
    y = y.reshape(Bsz, S, SSM_WIDTH) * norm_w
    return y.astype(z.dtype)


def hierarchical_moe(h, w_rg, b_rg, w_re, b_re, w_gate, w_up, w_down):
    Bsz, S, D = h.shape
    T = Bsz * S
    f32 = jnp.float32
    hf = h.reshape(T, D)
    g_logits = jnp.dot(hf, w_rg, preferred_element_type=f32) + b_rg
    p_group = jax.nn.softmax(g_logits, axis=-1)
    g_prob, g_idx = lax.top_k(p_group, 1)
    g_prob, g_idx = g_prob[:, 0], g_idx[:, 0]
    e_logits = jnp.einsum('td,gde->tge', hf, w_re, preferred_element_type=f32) + b_re
    e_logits = e_logits[jnp.arange(T), g_idx]
    top_logit, top_local = lax.top_k(e_logits, TOP_K)
    top_w = jax.nn.softmax(top_logit, axis=-1) * g_prob[:, None]
    expert_id = g_idx[:, None] * EXPERTS_PER_GROUP + top_local
    n_assign = T * TOP_K
    a_exp = expert_id.reshape(-1).astype(jnp.int32)
    a_tok = jnp.repeat(jnp.arange(T, dtype=jnp.int32), TOP_K)
    a_w = top_w.reshape(-1)
    order = jnp.argsort(a_exp)
    s_exp, s_tok, s_w = a_exp[order], a_tok[order], a_w[order]
    counts = jnp.bincount(a_exp, length=N_EXPERTS)
    starts = jnp.cumsum(counts) - counts
    padded = (counts + MOE_BLOCK - 1) // MOE_BLOCK * MOE_BLOCK
    pad_ends = jnp.cumsum(padded)
    pad_starts = pad_ends - padded
    dest = pad_starts[s_exp] + jnp.arange(n_assign, dtype=jnp.int32) - starts[s_exp]
    n_blocks = -(-n_assign // MOE_BLOCK) + N_EXPERTS
    cap = n_blocks * MOE_BLOCK
    buf_tok = jnp.zeros((cap,), jnp.int32).at[dest].set(s_tok)
    buf_w = jnp.zeros((cap,), f32).at[dest].set(s_w)
    block_exp = jnp.minimum(
        jnp.searchsorted(pad_ends, jnp.arange(n_blocks) * MOE_BLOCK, side='right'), N_EXPERTS - 1)

    def expert_block(args):
        tok, e = args
        xb = hf[tok]
        hid = jax.nn.silu(xb @ w_gate[e]) * (xb @ w_up[e])
        return hid @ w_down[e]

    ys = lax.map(expert_block, (buf_tok.reshape(n_blocks, MOE_BLOCK), block_exp))
    ys = ys.reshape(cap, D) * buf_w[:, None].astype(ys.dtype)
    out = jnp.zeros((T, D), ys.dtype).at[buf_tok].add(ys)
    return out.reshape(Bsz, S, D).astype(h.dtype)


def setup_inputs(seed: int = 0) -> dict:
    key = jax.random.key(seed)
    ks = jax.random.split(key, 26)
    L, D, f32 = DEPTH, D_MODEL, jnp.float32

    def nrm(k, shape, scale):
        return jax.random.normal(k, shape, f32) * scale

    x = nrm(ks[0], (BATCH, SEQ, D), 1.0)
    col_scale = jnp.concatenate([jnp.ones((N_Q + N_K,), f32), jnp.full((N_V,), DN_BETA, f32),
                                 jnp.ones((N_Z + N_XBC + N_DT,), f32)])
    w_in = nrm(ks[1], (L, D, IN_COLS), D ** -0.5) * col_scale
    lambda_q1 = nrm(ks[2], (L, ATT_HEAD_DIM), 0.1)
    lambda_k1 = nrm(ks[3], (L, ATT_HEAD_DIM), 0.1)
    lambda_q2 = nrm(ks[4], (L, ATT_HEAD_DIM), 0.1)
    lambda_k2 = nrm(ks[5], (L, ATT_HEAD_DIM), 0.1)
    attn_norm_w = 1.0 + nrm(ks[6], (L, ATT_V_DIM), 0.02)
    conv_w = nrm(ks[7], (L, SSM_CONV, N_XBC), SSM_CONV ** -0.5)
    conv_b = nrm(ks[8], (L, N_XBC), 0.02)
    dt0 = jnp.exp(jax.random.uniform(ks[9], (L, SSM_HEADS), f32, math.log(1e-3), math.log(1e-1)))
    dt_bias = dt0 + jnp.log(-jnp.expm1(-dt0))
    a_log = jnp.log(jax.random.uniform(ks[10], (L, SSM_HEADS), f32, 1.0, 16.0))
    d_skip = 1.0 + nrm(ks[11], (L, SSM_HEADS), 0.02)
    ssm_norm_w = 1.0 + nrm(ks[12], (L, SSM_WIDTH), 0.02)
    w_out = nrm(ks[13], (L, MIX_WIDTH, D), MIX_WIDTH ** -0.5 * DN_BETA)
    ln1_g = 1.0 + nrm(ks[14], (L, D), 0.02)
    ln1_b = nrm(ks[15], (L, D), 0.02)
    w_router_group = nrm(ks[16], (L, D, N_EXPERT_GROUPS), D ** -0.5)
    b_router_group = nrm(ks[17], (L, N_EXPERT_GROUPS), 0.01)
    w_router_expert = nrm(ks[18], (L, N_EXPERT_GROUPS, D, EXPERTS_PER_GROUP), D ** -0.5)
    b_router_expert = nrm(ks[19], (L, N_EXPERT_GROUPS, EXPERTS_PER_GROUP), 0.01)
    w_gate = nrm(ks[20], (L, N_EXPERTS, D, EXPERT_HIDDEN), D ** -0.5)
    w_up = nrm(ks[21], (L, N_EXPERTS, D, EXPERT_HIDDEN), D ** -0.5 * DN_BETA)
    w_down = nrm(ks[22], (L, N_EXPERTS, EXPERT_HIDDEN, D), EXPERT_HIDDEN ** -0.5 * DN_BETA)
    ln2_g = 1.0 + nrm(ks[23], (L, D), 0.02)
    ln2_b = nrm(ks[24], (L, D), 0.02)
    return {"x": x, "w_in": w_in, "lambda_q1": lambda_q1, "lambda_k1": lambda_k1,
            "lambda_q2": lambda_q2, "lambda_k2": lambda_k2, "attn_norm_w": attn_norm_w,
            "conv_w": conv_w, "conv_b": conv_b, "dt_bias": dt_bias, "a_log": a_log,
            "d_skip": d_skip, "ssm_norm_w": ssm_norm_w, "w_out": w_out,
            "ln1_g": ln1_g, "ln1_b": ln1_b, "w_router_group": w_router_group,
            "b_router_group": b_router_group, "w_router_expert": w_router_expert,
            "b_router_expert": b_router_expert, "w_gate": w_gate, "w_up": w_up,
            "w_down": w_down, "ln2_g": ln2_g, "ln2_b": ln2_b}


def reference(x, w_in, lambda_q1, lambda_k1, lambda_q2, lambda_k2, attn_norm_w, conv_w, conv_b,
              dt_bias, a_log, d_skip, ssm_norm_w, w_out, ln1_g, ln1_b, w_router_group,
              b_router_group, w_router_expert, b_router_expert, w_gate, w_up, w_down,
              ln2_g, ln2_b):
    Bsz, S, _ = x.shape
    f32 = jnp.float32
    offs = [N_Q, N_Q + N_K, N_Q + N_K + N_V, N_Q + N_K + N_V + N_Z,
            N_Q + N_K + N_V + N_Z + N_XBC]
    h = x
    for l in range(DEPTH):
        lambda_init = 0.8 - 0.6 * math.exp(-0.3 * l)
        proj = jnp.einsum('bsd,dc->bsc', h, w_in[l])
        q, k, v, z, xbc, dt_raw = jnp.split(proj, offs, axis=-1)
        q = q.reshape(Bsz, S, ATT_HEADS, 2, ATT_HEAD_DIM)
        k = k.reshape(Bsz, S, ATT_HEADS, 2, ATT_HEAD_DIM)
        v = v.reshape(Bsz, S, ATT_HEADS, ATT_V_DIM)
        lam = (jnp.exp(jnp.sum(lambda_q1[l].astype(f32) * lambda_k1[l].astype(f32)))
               - jnp.exp(jnp.sum(lambda_q2[l].astype(f32) * lambda_k2[l].astype(f32)))
               + lambda_init)
        att = diff_attention(q, k, v, lam, lambda_init, attn_norm_w[l])
        ssm = ssd_mixer(z, xbc, dt_raw, conv_w[l], conv_b[l], dt_bias[l], a_log[l],
                        d_skip[l], ssm_norm_w[l])
        mix = jnp.einsum('bsc,cd->bsd', jnp.concatenate([att, ssm], axis=-1), w_out[l])
        h = layer_norm(DN_ALPHA * h + mix, ln1_g[l], ln1_b[l])
        ffn = hierarchical_moe(h, w_router_group[l], b_router_group[l], w_router_expert[l],
                               b_router_expert[l], w_gate[l], w_up[l], w_down[l])
        h = layer_norm(DN_ALPHA * h + ffn, ln2_g[l], ln2_b[l])
    return h
```

```cpp
#include <hip/hip_runtime.h>
#include <cstdio>
#include <cstdint>
#include <cstddef>
#ifndef F8_UNSCALED
#define F8_UNSCALED 1
#endif
namespace pg8 {
#define PG8_LAS __attribute__((address_space(3)))
typedef unsigned short bf16_t;
typedef short bf16x8 __attribute__((ext_vector_type(8)));
typedef float f32x4 __attribute__((ext_vector_type(4)));
typedef unsigned u32x4 __attribute__((ext_vector_type(4)));
typedef int i32x8 __attribute__((ext_vector_type(8)));
typedef int i32x4 __attribute__((ext_vector_type(4)));
constexpr int BM = 256, BK = 64, HALF = 128, HTB = HALF * BK * 2, STAGE_BYTES = 8 * HTB, NXCD = 8, WGM = 8;

__host__ __device__ __forceinline__ int lds_byte(int r, int c) { const int st = (r >> 4) * 2 + (c >> 5), rr = r & 15, cc = c & 31, ob = rr * 64 + cc * 2; return st * 1024 + (ob ^ (((ob >> 9) & 1) << 5)); }
__host__ __device__ __forceinline__ void stage_rc(int b, int& R, int& C) { const int st = b / 1024, sb = b % 1024, swz = sb ^ (((sb >> 9) & 1) << 5); R = (st >> 1) * 16 + swz / 64; C = (st & 1) * 32 + (swz % 64) / 2; }
__host__ __device__ __forceinline__ int perm32(int rho) { const int n = rho >> 4, i = rho & 15; return 8 * (i >> 2) + 4 * n + (i & 3); }

struct UnitP { const char* A; const char* B; unsigned ao[2][2]; int row0; int col0; int aux; int vr; };

__device__ __forceinline__ unsigned cvt_pk_bf16(float lo, float hi) { unsigned r; asm volatile("v_cvt_pk_bf16_f32 %0, %1, %2" : "=v"(r) : "v"(lo), "v"(hi)); return r; }

struct DenseSched {
    static constexpr bool RAGGED = false;
    const char* A; const char* Bt; int K; int nM, nN, nwg, G, c;
    __device__ __forceinline__ void init(const void* A_, const void* Bt_, int M, int N, int K_, int G_, int c_) { A = (const char*)A_; Bt = (const char*)Bt_; K = K_; nM = M / BM; nN = N / BM; nwg = nM * nN; G = G_; c = c_; }
    __device__ __forceinline__ bool get(int i, UnitP& u, const int (&R)[2], const int (&C)[2]) const {
        const long L = (long)i * G + c; if (L >= nwg) return false;
        int wgid = (int)L; { const int q = nwg / NXCD, r = nwg % NXCD, xcd = wgid % NXCD, off = wgid / NXCD; wgid = (xcd < r ? xcd * (q + 1) : r * (q + 1) + (xcd - r) * q) + off; }
        const int nig = WGM * nN, gid = wgid / nig, fm = gid * WGM, gsz = (nM - fm) < WGM ? (nM - fm) : WGM;
        const int pm = fm + ((wgid % nig) % gsz), pn = (wgid % nig) / gsz;
        const size_t tstep = (size_t)BM * K * 2;
        u.A = A + (size_t)pm * tstep; u.B = Bt + (size_t)pn * tstep; u.row0 = pm * BM; u.col0 = pn * BM; u.aux = pn; u.vr = BM;
#pragma unroll
        for (int h = 0; h < 2; ++h)
#pragma unroll
            for (int i2 = 0; i2 < 2; ++i2) u.ao[h][i2] = (unsigned)((h * HALF + R[i2]) * K + C[i2]) * 2u;
        return true;
    }
};

template <class Epi, class Sched, bool ALIGN_EPI, bool F8 = false, int SCALE_W = 127>
__device__ __forceinline__ void gemm_phase(PG8_LAS unsigned char* lds, const int K, const Sched& S, const Epi& E) {
    const int tid = threadIdx.x, wid = __builtin_amdgcn_readfirstlane(tid >> 6), lane = tid & 63, wr = wid >> 2, wc = wid & 3, fr = lane & 15, fq = lane >> 4;
    const int nt = K / BK;
    int R[2], C[2]; unsigned voffB[2];
#pragma unroll
    for (int i = 0; i < 2; ++i) { stage_rc(tid * 16 + i * 8192, R[i], C[i]); const int Rb = Epi::PERM ? ((R[i] & ~31) + perm32(R[i] & 31)) : R[i]; voffB[i] = (unsigned)(Rb * K + C[i]) * 2u; }
    const size_t kstep = (size_t)(BK * 2);
    const size_t hstep = (size_t)HALF * K * 2;
    const unsigned ldsw = (unsigned)wid * 1024u;
    const unsigned lds0 = (unsigned)(uintptr_t)lds;
    const int aoff = lds_byte(wr * 64 + fr, fq * 8), boff = lds_byte(wc * 32 + fr, fq * 8);
#define PG8_SA(b, h) (((b) * 2 + (h)) * HTB)
#define PG8_SB(b, h) ((4 + (b) * 2 + (h)) * HTB)
#define PG8_GLDS(gbase, voff32, ldsaddr) do { unsigned keep_; asm volatile("s_mov_b32 %0, m0\n\ts_mov_b32 m0, %3\n\ts_nop 0\n\tglobal_load_lds_dwordx4 %1, %2\n\ts_mov_b32 m0, %0" \
        : "=&s"(keep_) : "v"(voff32), "s"(gbase), "s"(ldsaddr) : "memory"); } while (0)
#define PG8_STAGE_B(bufoff, gbase) do { _Pragma("unroll") for (int _i = 0; _i < 2; ++_i) PG8_GLDS((const char*)(gbase), voffB[_i], lds0 + (unsigned)(bufoff) + ldsw + (unsigned)(_i * 8192)); } while (0)
#define PG8_STAGE_A(bufoff, gbase, offs) do { _Pragma("unroll") for (int _i = 0; _i < 2; ++_i) PG8_GLDS((const char*)(gbase), (offs)[_i], lds0 + (unsigned)(bufoff) + ldsw + (unsigned)(_i * 8192)); } while (0)
#define PG8_LDA(dst, b, h) do { _Pragma("unroll") for (int m = 0; m < 4; ++m) { \
        { const i32x4 lo_ = *(const PG8_LAS i32x4*)(lds + PG8_SA(b, h) + aoff + m * 2048), hi_ = *(const PG8_LAS i32x4*)(lds + PG8_SA(b, h) + aoff + m * 2048 + 1024); dst[m] = __builtin_shufflevector(lo_, hi_, 0, 1, 2, 3, 4, 5, 6, 7); } } } while (0)
#define PG8_LDB(dst, b, h) do { _Pragma("unroll") for (int n = 0; n < 2; ++n) { \
        { const i32x4 lo_ = *(const PG8_LAS i32x4*)(lds + PG8_SB(b, h) + boff + n * 2048), hi_ = *(const PG8_LAS i32x4*)(lds + PG8_SB(b, h) + boff + n * 2048 + 1024); dst[n] = __builtin_shufflevector(lo_, hi_, 0, 1, 2, 3, 4, 5, 6, 7); } } } while (0)
#define PG8_MMA(ai, bj, At, Bt) do { __builtin_amdgcn_s_setprio(1); _Pragma("unroll") for (int m = 0; m < 4; ++m) _Pragma("unroll") for (int n = 0; n < 2; ++n) { \
        if constexpr (F8) { if (F8_UNSCALED) asm volatile("v_mfma_f32_16x16x128_f8f6f4 %0, %1, %2, %0" : "+v"(acc[ai][bj][m][n]) : "v"(Bt[n]), "v"(At[m])); \
            else asm volatile("v_mfma_scale_f32_16x16x128_f8f6f4 %0, %1, %2, %0, %3, %4 op_sel_hi:[0,0,0]" : "+v"(acc[ai][bj][m][n]) : "v"(Bt[n]), "v"(At[m]), "v"(sc_w), "v"(sc_a)); } \
        else { const i32x8 b_ = Bt[n], a_ = At[m]; \
            acc[ai][bj][m][n] = __builtin_amdgcn_mfma_f32_16x16x32_bf16(__builtin_bit_cast(bf16x8, __builtin_shufflevector(b_, b_, 0, 1, 2, 3)), __builtin_bit_cast(bf16x8, __builtin_shufflevector(a_, a_, 0, 1, 2, 3)), acc[ai][bj][m][n], 0, 0, 0); \
            acc[ai][bj][m][n] = __builtin_amdgcn_mfma_f32_16x16x32_bf16(__builtin_bit_cast(bf16x8, __builtin_shufflevector(b_, b_, 4, 5, 6, 7)), __builtin_bit_cast(bf16x8, __builtin_shufflevector(a_, a_, 4, 5, 6, 7)), acc[ai][bj][m][n], 0, 0, 0); } } \
        __builtin_amdgcn_s_setprio(0); } while (0)
#define PG8_WAIT_V(n) asm volatile("s_waitcnt vmcnt(" #n ")" ::: "memory")
#define PG8_WAIT_L(n) asm volatile("s_waitcnt lgkmcnt(" #n ")" ::: "memory")
#define PG8_BAR __builtin_amdgcn_s_barrier()
#define PG8_SCHED __builtin_amdgcn_sched_barrier(0)
    UnitP cur, nxt; int ui = 0;
    if (!S.get(0, cur, R, C)) return;
    f32x4 acc[2][2][4][2];
#pragma unroll
    for (int a = 0; a < 2; ++a)
#pragma unroll
        for (int b = 0; b < 2; ++b)
#pragma unroll
            for (int m = 0; m < 4; ++m)
#pragma unroll
                for (int n = 0; n < 2; ++n) acc[a][b][m][n] = (f32x4){0.f, 0.f, 0.f, 0.f};
    int sc_w = SCALE_W, sc_a = 127; if constexpr (F8) asm volatile("" : "+v"(sc_w), "+v"(sc_a));
    i32x8 At[4], B0[2], B1[2];
    {
        const char* cA = cur.A; const char* cB = cur.B;
        PG8_STAGE_B(PG8_SB(0, 0), cB); PG8_STAGE_B(PG8_SB(0, 1), cB + hstep); PG8_STAGE_A(PG8_SA(0, 0), cA, cur.ao[0]); PG8_STAGE_A(PG8_SA(0, 1), cA, cur.ao[1]);
        if (wr == 1) PG8_BAR;
        PG8_WAIT_V(2); PG8_BAR;
        PG8_STAGE_B(PG8_SB(1, 0), cB + kstep); PG8_STAGE_A(PG8_SA(1, 0), cA + kstep, cur.ao[0]); PG8_STAGE_B(PG8_SB(1, 1), cB + hstep + kstep);
        PG8_WAIT_V(6); PG8_BAR;
    }
    for (;;) {
        const bool has_next = S.get(ui + 1, nxt, R, C);
        if (!has_next) nxt = cur;
        const char* cA = cur.A; const char* cB = cur.B; const char* nA = nxt.A; const char* nB = nxt.B;
        const bool va0 = !Sched::RAGGED || cur.vr > wr * 64, va1 = !Sched::RAGGED || cur.vr > 128 + wr * 64;
#pragma nounroll
        for (int t = 0; t < nt; t += 2) {
            const bool last = (t == nt - 2);
            const char* a1 = cA + (size_t)(t + 1) * kstep;
            const char* a2 = last ? nA : cA + (size_t)(t + 2) * kstep; const char* b2 = last ? nB : cB + (size_t)(t + 2) * kstep;
            const char* a3 = a2 + kstep; const char* b3 = b2 + kstep;
            unsigned o2[2][2];
#pragma unroll
            for (int h = 0; h < 2; ++h)
#pragma unroll
                for (int i = 0; i < 2; ++i) o2[h][i] = last ? nxt.ao[h][i] : cur.ao[h][i];
            if (va0) { PG8_LDB(B0, 0, 0); PG8_LDB(B1, 0, 1); } PG8_SCHED; if (va0) PG8_LDA(At, 0, 0); PG8_STAGE_A(PG8_SA(1, 1), a1, cur.ao[1]);
            PG8_WAIT_V(8); PG8_WAIT_L(0); PG8_BAR; if (va0) { PG8_MMA(0, 0, At, B0); PG8_MMA(0, 1, At, B1); } PG8_BAR; PG8_SCHED;
            if (va1) PG8_LDA(At, 0, 1); PG8_STAGE_B(PG8_SB(0, 0), b2); PG8_STAGE_B(PG8_SB(0, 1), b2 + hstep); PG8_STAGE_A(PG8_SA(0, 0), a2, o2[0]);
            PG8_WAIT_V(8); PG8_WAIT_L(0); PG8_BAR; if (va1) { PG8_MMA(1, 0, At, B0); PG8_MMA(1, 1, At, B1); } PG8_BAR; PG8_SCHED;
            if (va0) { PG8_LDB(B0, 1, 0); PG8_LDB(B1, 1, 1); } PG8_SCHED; if (va0) PG8_LDA(At, 1, 0); PG8_STAGE_A(PG8_SA(0, 1), a2, o2[1]);
            PG8_WAIT_V(8); PG8_WAIT_L(0); PG8_BAR; if (va0) { PG8_MMA(0, 0, At, B0); PG8_MMA(0, 1, At, B1); } PG8_BAR; PG8_SCHED;
            if (va1) PG8_LDA(At, 1, 1); PG8_STAGE_B(PG8_SB(1, 0), b3); PG8_STAGE_B(PG8_SB(1, 1), b3 + hstep); PG8_STAGE_A(PG8_SA(1, 0), a3, o2[0]);
            PG8_WAIT_V(8); PG8_WAIT_L(0); PG8_BAR; if (va1) { PG8_MMA(1, 0, At, B0); PG8_MMA(1, 1, At, B1); } PG8_BAR; PG8_SCHED;
        }
        if constexpr (ALIGN_EPI) { if (wr == 0) PG8_BAR; }
        if constexpr (F8) asm volatile("s_nop 15\n\ts_nop 15" ::: "memory");
        E(acc, cur, wr, wc, fr, fq);
        if (!has_next) break;
#pragma unroll
        for (int a = 0; a < 2; ++a)
#pragma unroll
            for (int b = 0; b < 2; ++b)
#pragma unroll
                for (int m = 0; m < 4; ++m)
#pragma unroll
                    for (int n = 0; n < 2; ++n) acc[a][b][m][n] = (f32x4){0.f, 0.f, 0.f, 0.f};
        cur = nxt; ++ui;
        if constexpr (ALIGN_EPI) { if (wr == 1) PG8_BAR; }
    }
    PG8_WAIT_V(0);
    if constexpr (!ALIGN_EPI) { if (wr == 0) PG8_BAR; }
    PG8_BAR;
#undef PG8_SA
#undef PG8_SB
#undef PG8_STAGE_A
#undef PG8_GLDS
#undef PG8_STAGE_B
#undef PG8_LDA
#undef PG8_LDB
#undef PG8_MMA
#undef PG8_WAIT_V
#undef PG8_WAIT_L
#undef PG8_BAR
#undef PG8_SCHED
}
}
constexpr int NWAVES = 8;
constexpr int NB = 4, SEQ = 8192, T = NB * SEQ, DM = 2048;
constexpr int PITCH = 5632;
constexpr int QC = 0, KC = 1024, VC = 2048, ZC = 3072, XC = 4096;
constexpr int IN_COLS = 5648;
constexpr int NEXP = 32, EHID = 1024;
constexpr int CAP_ROWS = (2 * T / 256 + NEXP) * 256;
constexpr float DN_ALPHA = 1.189207115002721f;
constexpr float LN_EPS = 1e-5f, RMS_EPS = 1e-6f;
constexpr float LOG2E = 1.4426950408889634f;
constexpr float QSCALE = 0.125f * LOG2E;

constexpr size_t MiB = 1u << 20;
constexpr size_t WS_CTL = 0, CTL_ZERO_BYTES = 1 * MiB;
constexpr size_t WS_DT = 2 * MiB;
constexpr size_t WS_RT = 4 * MiB;
constexpr size_t WS_LIST = 5 * MiB;
constexpr size_t WS_STAT = 9 * MiB;
constexpr size_t WS_CD = 17 * MiB;
constexpr size_t WS_NRM = 17 * MiB + 512 * 1024;
constexpr size_t WS_WRT = 18 * MiB;
constexpr size_t WS_WIN = 20 * MiB;
constexpr size_t WS_WOUT = 42 * MiB;
constexpr size_t WS_WDN = 50 * MiB;
constexpr size_t WS_WGU = 178 * MiB;
constexpr size_t WS_CONV = 306 * MiB;
constexpr size_t WS_XB = 434 * MiB;
constexpr size_t WS_PROJ = 562 * MiB;
constexpr size_t WS_H1B = WS_PROJ;
constexpr size_t WS_Y = WS_PROJ;
constexpr size_t WS_MR = WS_NRM;
constexpr size_t WS_HID = WS_PROJ + 128 * MiB;
constexpr size_t WS_YMOE = WS_WGU;
constexpr size_t WS_H1F8 = WS_PROJ + 200 * MiB;
constexpr size_t WS_END = 914 * MiB;
static_assert(WS_CONV + (size_t)T * 1280 * 2 <= WS_XB, "conv cache fits below xb");
static_assert(WS_HID + (size_t)CAP_ROWS * EHID * 2 <= WS_END, "hid fits in proj region");
static_assert(WS_YMOE + (size_t)CAP_ROWS * DM * 2 <= WS_PROJ, "ymoe fits below proj");
constexpr int CW_TMO = 0, CW_CODE = 1;
constexpr int CW_CNT = 8192;
constexpr int CW_SBQ = 2048, CW_SBDONE = 2112, CW_SCQ = 2176;
constexpr int CW_CVQ = 192;
constexpr int CW_ATTQ = 256;
constexpr int CW_BAR = 4096;

constexpr int RING_OFF = 0, RING_BYTES = 131072;
constexpr int LDSCTL_OFF = RING_BYTES, MISC_OFF = LDSCTL_OFF + 320;
constexpr int TAB_OFF = LDSCTL_OFF + 1024;
constexpr int LDS_BYTES = 147456;

#ifndef MOE_F8
#define MOE_F8 1
#endif
#ifndef MOE_DEFER
#define MOE_DEFER (MOE_F8 ? 1 : 0)
#endif
#ifndef CVT_MASK
#define CVT_MASK 3
#endif
#define GAS __attribute__((address_space(1)))
#define LAS __attribute__((address_space(3)))
typedef unsigned short bf16;
typedef unsigned v4u __attribute__((ext_vector_type(4)));
typedef unsigned v2u __attribute__((ext_vector_type(2)));
typedef float f32x4 __attribute__((ext_vector_type(4)));
typedef float f32x2 __attribute__((ext_vector_type(2)));
typedef float f32x16 __attribute__((ext_vector_type(16)));
typedef short bf16x8 __attribute__((ext_vector_type(8)));
typedef short s16x4 __attribute__((ext_vector_type(4)));
typedef GAS unsigned gu32;
#define RLX_AGENT __ATOMIC_RELAXED, __HIP_MEMORY_SCOPE_AGENT
#define LDS_WAIT() asm volatile("s_waitcnt lgkmcnt(0)" ::: "memory")
#define VM_WAIT() asm volatile("s_waitcnt vmcnt(0)" ::: "memory")
__device__ __forceinline__ unsigned f2bf(float f) { unsigned u = __builtin_bit_cast(unsigned, f); return (u + 0x7fffu + ((u >> 16) & 1u)) >> 16; }
__device__ __forceinline__ unsigned pk2(float lo, float hi) { return f2bf(lo) | (f2bf(hi) << 16); }
__device__ __forceinline__ unsigned pk4_fp8(float a, float b, float c, float d) { int r = __builtin_amdgcn_cvt_pk_fp8_f32(a, b, 0, false); r = __builtin_amdgcn_cvt_pk_fp8_f32(c, d, r, true); return (unsigned)r; }
__device__ __forceinline__ float bflo(unsigned u) { return __builtin_bit_cast(float, u << 16); }
__device__ __forceinline__ float bfhi(unsigned u) { return __builtin_bit_cast(float, u & 0xffff0000u); }
__device__ __forceinline__ float wave_sum(float v) {
#pragma unroll
    for (int o = 1; o < 64; o <<= 1) v += __shfl_xor(v, o);
    return v;
}

#define XB_TMO      128
#define XB_XCNT(j)  (256  + 64 * (j))
#define XB_XSUB(j)  (1280 + 64 * (j))
#define XB_XGEN(j)  (2304 + 64 * (j))
#define XB_TOP      3328
#define XB_TOPGEN   3392
#define XCD_BAR_WORDS 3456
#define XB_SPIN_CAP (1u << 18)

__device__ __forceinline__ unsigned xb_ld(unsigned* p)              { return __hip_atomic_load(p, __ATOMIC_RELAXED, __HIP_MEMORY_SCOPE_AGENT); }
__device__ __forceinline__ unsigned xb_add(unsigned* p, unsigned v) { return __hip_atomic_fetch_add(p, v, __ATOMIC_RELAXED, __HIP_MEMORY_SCOPE_AGENT); }
__device__ __forceinline__ unsigned xb_xcc_id() { return (unsigned)__builtin_amdgcn_s_getreg((3 << 11) | 20) & 0xFu; }
#define XB_SPIN(cond, bar) do { unsigned _sp = 0; while (cond) { __builtin_amdgcn_s_sleep(1); \
    if ((++_sp & 255u) == 0u) { if (xb_ld(&(bar)[XB_TMO])) break; if (_sp > XB_SPIN_CAP) { atomicAdd(&(bar)[XB_TMO], 1u); break; } } } } while (0)

struct XcdBarrier { unsigned* bar; unsigned x; volatile LAS unsigned* st; };

__device__ __forceinline__ XcdBarrier xcd_barrier_post(unsigned* bar, volatile LAS unsigned* st) {
    XcdBarrier b; b.bar = bar; b.x = xb_xcc_id(); b.st = st;
    if (threadIdx.x == 0) (void)xb_add(&bar[XB_XCNT(b.x)], 1u);
    return b;
}
__device__ __forceinline__ void xcd_barrier_complete(unsigned* bar, unsigned x, unsigned& nloc, unsigned& nx) {
    const unsigned G = gridDim.x * gridDim.y * gridDim.z;
    unsigned sum, cnt, mine, sp = 0u;
    for (;;) {
        sum = 0u; cnt = 0u; mine = 0u;
#pragma unroll
        for (unsigned j = 0; j < 16; ++j) { const unsigned c = xb_ld(&bar[XB_XCNT(j)]); sum += c; cnt += (c > 0u) ? 1u : 0u; mine = (j == x) ? c : mine; }
        if (sum == G) break;
        __builtin_amdgcn_s_sleep(1);
        if ((++sp & 255u) == 0u) { if (xb_ld(&bar[XB_TMO])) break; if (sp > XB_SPIN_CAP) { atomicAdd(&bar[XB_TMO], 1u); break; } }
    }
    nloc = mine > 0u ? mine : 1u; nx = cnt > 0u ? cnt : 1u;
}
__device__ __forceinline__ void xcd_barrier(const XcdBarrier& b) {
    asm volatile("s_waitcnt vmcnt(0)" ::: "memory");
    __syncthreads();
    if (threadIdx.x == 0) {
        unsigned* bar = b.bar;
        __builtin_amdgcn_s_waitcnt(0);
        unsigned nloc = b.st[0], nx = b.st[1];
        if (nloc == 0u) { xcd_barrier_complete(bar, b.x, nloc, nx); b.st[0] = nloc; b.st[1] = nx; }
        const unsigned old = xb_add(&bar[XB_XSUB(b.x)], 1u);
        const unsigned gen = old / nloc;
        if (old + 1u == (gen + 1u) * nloc) {
            __builtin_amdgcn_fence(__ATOMIC_RELEASE, "agent");
            asm volatile("s_waitcnt vmcnt(0)" ::: "memory");
            const unsigned og = xb_add(&bar[XB_TOP], 1u);
            const unsigned tg = og / nx;
            if (og + 1u == (tg + 1u) * nx) xb_add(&bar[XB_TOPGEN], 1u);
            else XB_SPIN(xb_ld(&bar[XB_TOPGEN]) == tg, bar);
            __builtin_amdgcn_fence(__ATOMIC_ACQUIRE, "agent");
            xb_add(&bar[XB_XGEN(b.x)], 1u);
            asm volatile("s_waitcnt vmcnt(0)" ::: "memory");
        } else {
            XB_SPIN(xb_ld(&bar[XB_XGEN(b.x)]) == gen, bar);
            __builtin_amdgcn_fence(__ATOMIC_ACQUIRE, "agent");
            asm volatile("s_waitcnt vmcnt(0)" ::: "memory");
        }
    }
    __syncthreads();
}

struct Frame {
    LAS unsigned char* lds;
    volatile LAS unsigned* MISC;
    gu32* ctl;
    int tid, lane, wave;
    int vcu, G;
    const float* in[25];
    float* out;
    unsigned char* ws;
};
#define WSP(T_, off) ((T_*)(F.ws + (off)))
typedef short v4i16_t __attribute__((ext_vector_type(4)));
__device__ __forceinline__ s16x4 lds_tr16(LAS const unsigned char* p) { return __builtin_bit_cast(s16x4, __builtin_amdgcn_ds_read_tr16_b64_v4i16((LAS v4i16_t*)p)); }

__device__ __forceinline__ void p0_tr_item(const float* __restrict__ W, size_t ld, bf16* __restrict__ WT, size_t Kd, LAS unsigned char* scr, int lane) {
    const int rs = lane >> 4, c = lane & 15;
    f32x4 v[16];
#pragma unroll
    for (int j = 0; j < 16; ++j) v[j] = *(const f32x4*)(W + (size_t)(4 * j + rs) * ld + 4 * c);
#pragma unroll
    for (int j = 0; j < 16; ++j) { v2u o; o.x = pk2(v[j].x, v[j].y); o.y = pk2(v[j].z, v[j].w); *(LAS v2u*)(scr + (4 * j + rs) * 160 + 8 * c) = o; }
    LDS_WAIT(); asm volatile("" ::: "memory");
    const int q = (lane & 15) >> 2, p = lane & 3, gg = lane >> 4, i = lane & 15;
#pragma unroll
    for (int s = 0; s < 8; ++s) {
        const int nb = s >> 1, kp = 8 * ((s & 1) * 4 + gg);
        const s16x4 lo = lds_tr16(scr + (kp + q) * 160 + (16 * nb + 4 * p) * 2);
        const s16x4 hi = lds_tr16(scr + (kp + 4 + q) * 160 + (16 * nb + 4 * p) * 2);
        const bf16x8 o = __builtin_shufflevector(lo, hi, 0, 1, 2, 3, 4, 5, 6, 7);
        *(bf16x8*)(WT + (size_t)(16 * nb + i) * Kd + kp) = o;
    }
    LDS_WAIT(); asm volatile("" ::: "memory");
}

__device__ __forceinline__ void p0_tr_item8(const float* __restrict__ W, size_t ld, unsigned char* __restrict__ WT8, size_t Kd, LAS unsigned char* scr, int lane, float scale) {
    const int rs = lane >> 4, c = lane & 15;
#pragma unroll
    for (int hb = 0; hb < 2; ++hb) {
        f32x4 va[8], vb[8];
#pragma unroll
        for (int j = 0; j < 8; ++j) { const int kp = 32 * hb + 4 * j + rs; va[j] = *(const f32x4*)(W + (size_t)(2 * kp) * ld + 4 * c); vb[j] = *(const f32x4*)(W + (size_t)(2 * kp + 1) * ld + 4 * c); }
#pragma unroll
        for (int j = 0; j < 8; ++j) { const int kp = 32 * hb + 4 * j + rs; const f32x4 a = va[j] * scale, b = vb[j] * scale;
            v2u o; o.x = pk4_fp8(a.x, b.x, a.y, b.y); o.y = pk4_fp8(a.z, b.z, a.w, b.w); *(LAS v2u*)(scr + kp * 160 + 8 * c) = o; }
    }
    LDS_WAIT(); asm volatile("" ::: "memory");
    const int q = (lane & 15) >> 2, p = lane & 3, gg = lane >> 4, i = lane & 15;
#pragma unroll
    for (int s = 0; s < 8; ++s) {
        const int nb = s >> 1, kp = 8 * ((s & 1) * 4 + gg);
        const s16x4 lo = lds_tr16(scr + (kp + q) * 160 + (16 * nb + 4 * p) * 2);
        const s16x4 hi = lds_tr16(scr + (kp + 4 + q) * 160 + (16 * nb + 4 * p) * 2);
        const bf16x8 o = __builtin_shufflevector(lo, hi, 0, 1, 2, 3, 4, 5, 6, 7);
        *(bf16x8*)(WT8 + (size_t)(16 * nb + i) * Kd + 2 * kp) = o;
    }
    LDS_WAIT(); asm volatile("" ::: "memory");
}

__device__ __forceinline__ void p0_prologue(Frame& F) {
    const float* x = F.in[0]; const float* w_in = F.in[1];
    {
        LAS float* wdt = (LAS float*)(F.lds + RING_OFF);
        for (int idx = F.tid; idx < 2048 * 16; idx += NWAVES * 64) { const int k = idx >> 4, col = idx & 15; wdt[col * 2052 + k] = w_in[(size_t)k * IN_COLS + 5632 + col]; }
        __syncthreads();
        bf16* XB = WSP(bf16, WS_XB); float* DT = WSP(float, WS_DT);
        const int r = F.lane & 15, kq = F.lane >> 4;
        for (int grp = F.vcu * NWAVES + F.wave; grp < T / 16; grp += F.G * NWAVES) {
            const float* xrow = x + (size_t)(grp * 16 + r) * DM + 8 * kq;
            bf16* xbrow = XB + (size_t)(grp * 16 + r) * DM + 8 * kq;
            LAS const float* wrow = wdt + r * 2052 + 8 * kq;
            f32x4 acc = (f32x4){0.f, 0.f, 0.f, 0.f};
            f32x4 xq[2][8][2];
#pragma unroll
            for (int j = 0; j < 8; ++j) { xq[0][j][0] = *(const f32x4*)(xrow + 32 * j); xq[0][j][1] = *(const f32x4*)(xrow + 32 * j + 4); }
#pragma nounroll
            for (int b2 = 0; b2 < 4; ++b2) {
#pragma unroll
                for (int hb = 0; hb < 2; ++hb) {
                    const int blk = 2 * b2 + hb;
                    if (blk < 7) {
#pragma unroll
                        for (int j = 0; j < 8; ++j) { xq[hb ^ 1][j][0] = *(const f32x4*)(xrow + 32 * (8 * (blk + 1) + j)); xq[hb ^ 1][j][1] = *(const f32x4*)(xrow + 32 * (8 * (blk + 1) + j) + 4); }
                    }
#pragma unroll
                    for (int j = 0; j < 8; ++j) {
                        const int s = 8 * blk + j;
                        const f32x4 a = xq[hb][j][0], a2 = xq[hb][j][1];
                        const f32x4 bw = *(LAS const f32x4*)(wrow + 32 * s), bw2 = *(LAS const f32x4*)(wrow + 32 * s + 4);
                        acc = __builtin_amdgcn_mfma_f32_16x16x4f32(a.x, bw.x, acc, 0, 0, 0);
                        acc = __builtin_amdgcn_mfma_f32_16x16x4f32(a.y, bw.y, acc, 0, 0, 0);
                        acc = __builtin_amdgcn_mfma_f32_16x16x4f32(a.z, bw.z, acc, 0, 0, 0);
                        acc = __builtin_amdgcn_mfma_f32_16x16x4f32(a.w, bw.w, acc, 0, 0, 0);
                        acc = __builtin_amdgcn_mfma_f32_16x16x4f32(a2.x, bw2.x, acc, 0, 0, 0);
                        acc = __builtin_amdgcn_mfma_f32_16x16x4f32(a2.y, bw2.y, acc, 0, 0, 0);
                        acc = __builtin_amdgcn_mfma_f32_16x16x4f32(a2.z, bw2.z, acc, 0, 0, 0);
                        acc = __builtin_amdgcn_mfma_f32_16x16x4f32(a2.w, bw2.w, acc, 0, 0, 0);
                        v4u o; o.x = pk2(a.x, a.y); o.y = pk2(a.z, a.w); o.z = pk2(a2.x, a2.y); o.w = pk2(a2.z, a2.w);
                        *(v4u*)(xbrow + 32 * s) = o;
                    }
                }
            }
#pragma unroll
            for (int rg = 0; rg < 4; ++rg) DT[(size_t)(grp * 16 + 4 * kq + rg) * 16 + r] = acc[rg];
        }
        __syncthreads();
    }
    {
        bf16* WRH = WSP(bf16, WS_WRT); bf16* WRL = WRH + 48 * 2048; const float* wrg = F.in[16]; const float* wre = F.in[18];
        for (int idx = F.vcu * NWAVES * 64 + F.tid; idx < 48 * 2048; idx += F.G * NWAVES * 64) {
            const int col = idx >> 11, k = idx & 2047; float v = 0.f;
            if (col < 4) v = wrg[k * 4 + col];
            else if (col < 36) { const int g = (col - 4) >> 3, e = (col - 4) & 7; v = wre[((size_t)g * 2048 + k) * 8 + e]; }
            const unsigned hi = f2bf(v); const float rem = v - bflo(hi);
            WRH[idx] = (bf16)hi; WRL[idx] = (bf16)f2bf(rem);
        }
    }
    {
        LAS unsigned char* scr = F.lds + RING_OFF + F.wave * 10240;
        const int gw = F.vcu * NWAVES + F.wave, NGW = F.G * NWAVES;
#if MOE_F8
        constexpr int I_IN = 32 * 88, I_OUT = 32 * 32, I_G = 16 * 16, I_D = 8 * 32;
#else
        constexpr int I_IN = 32 * 88, I_OUT = 32 * 32, I_G = 32 * 16, I_D = 16 * 32;
#endif
        constexpr int NITEMS = I_IN + I_OUT + (MOE_DEFER ? 0 : NEXP * (2 * I_G + I_D));
        bf16* WIN = WSP(bf16, WS_WIN); bf16* WOUT = WSP(bf16, WS_WOUT); bf16* WGU = WSP(bf16, WS_WGU); bf16* WDN = WSP(bf16, WS_WDN);
        for (int it = gw; it < NITEMS; it += NGW) {
            int r = it;
            if (r < I_IN) { const int kb = r / 88, nb = r % 88; p0_tr_item(w_in + (size_t)(64 * kb) * IN_COLS + 64 * nb, IN_COLS, WIN + (size_t)(64 * nb) * 2048 + 64 * kb, 2048, scr, F.lane); continue; }
            r -= I_IN;
            if (r < I_OUT) { const int kb = r / 32, nb = r % 32; p0_tr_item(F.in[13] + (size_t)(64 * kb) * 2048 + 64 * nb, 2048, WOUT + (size_t)(64 * nb) * 2048 + 64 * kb, 2048, scr, F.lane); continue; }
            r -= I_OUT;
            const int e = r / (2 * I_G + I_D); r -= e * (2 * I_G + I_D);
#if MOE_F8
            if (r < 2 * I_G) {
                const int up = r >= I_G; if (up) r -= I_G;
                const int kb = r / 16, nb = r % 16, n0 = 64 * nb;
                const float* src = (up ? F.in[21] : F.in[20]) + ((size_t)e * 2048 + 128 * kb) * 1024 + n0;
                const int drow = (n0 >> 7) * 256 + (n0 & 127) + (up ? 128 : 0);
                p0_tr_item8(src, 1024, (unsigned char*)WGU + ((size_t)e * 2048 + drow) * 2048 + 128 * kb, 2048, scr, F.lane, 64.f);
            } else {
                r -= 2 * I_G; const int kb = r / 32, nb = r % 32;
                p0_tr_item8(F.in[22] + ((size_t)e * 1024 + 128 * kb) * 2048 + 64 * nb, 2048, (unsigned char*)WDN + ((size_t)e * 2048 + 64 * nb) * 1024 + 128 * kb, 1024, scr, F.lane, 64.f);
            }
#else
            if (r < 2 * I_G) {
                const int up = r >= I_G; if (up) r -= I_G;
                const int kb = r / 16, nb = r % 16, n0 = 64 * nb;
                const float* src = (up ? F.in[21] : F.in[20]) + ((size_t)e * 2048 + 64 * kb) * 1024 + n0;
                const int drow = (n0 >> 7) * 256 + (n0 & 127) + (up ? 128 : 0);
                p0_tr_item(src, 1024, WGU + ((size_t)e * 2048 + drow) * 2048 + 64 * kb, 2048, scr, F.lane);
            } else {
                r -= 2 * I_G; const int kb = r / 32, nb = r % 32;
                p0_tr_item(F.in[22] + ((size_t)e * 1024 + 64 * kb) * 2048 + 64 * nb, 2048, WDN + ((size_t)e * 2048 + 64 * nb) * 1024 + 64 * kb, 1024, scr, F.lane);
            }
#endif
        }
    }
}

#if MOE_F8
__device__ __forceinline__ void moe_convert(Frame& F) {
    constexpr int I_G = 16 * 16, I_D = 8 * 32, PER_E = 2 * I_G + I_D, NCH = NEXP * PER_E / 8;
    LAS unsigned char* scr = F.lds + RING_OFF + F.wave * 10240;
    volatile LAS unsigned* qslot = F.MISC + 17;
    unsigned char* WGU = WSP(unsigned char, WS_WGU); unsigned char* WDN = WSP(unsigned char, WS_WDN);
    for (;;) {
        __syncthreads();
        if (F.tid == 0) *qslot = __hip_atomic_fetch_add(F.ctl + CW_CVQ, 1u, RLX_AGENT);
        __syncthreads();
        const unsigned ch = *qslot;
        if (ch >= (unsigned)NCH) break;
        int r = (int)ch * 8 + F.wave;
        const int e = r / PER_E; r -= e * PER_E;
        if (r < 2 * I_G) {
            const int up = r >= I_G; if (up) r -= I_G;
            const int kb = r / 16, nb = r % 16, n0 = 64 * nb;
            const float* src = (up ? F.in[21] : F.in[20]) + ((size_t)e * 2048 + 128 * kb) * 1024 + n0;
            const int drow = (n0 >> 7) * 256 + (n0 & 127) + (up ? 128 : 0);
            p0_tr_item8(src, 1024, WGU + ((size_t)e * 2048 + drow) * 2048 + 128 * kb, 2048, scr, F.lane, 64.f);
        } else {
            r -= 2 * I_G; const int kb = r / 32, nb = r % 32;
            p0_tr_item8(F.in[22] + ((size_t)e * 1024 + 128 * kb) * 2048 + 64 * nb, 2048, WDN + ((size_t)e * 2048 + 64 * nb) * 1024 + 128 * kb, 1024, scr, F.lane, 64.f);
        }
    }
    __syncthreads();
}
#endif
namespace att {
constexpr int STG = 32768, NST = 3;
__device__ __forceinline__ unsigned cvtpk(float lo, float hi) { typedef __bf16 bf2 __attribute__((ext_vector_type(2))); f32x2 v = {lo, hi}; bf2 b = __builtin_convertvector(v, bf2); return __builtin_bit_cast(unsigned, b); }
#define ATT_WAITBAR(N) asm volatile("s_waitcnt vmcnt(" #N ") lgkmcnt(0)\n\ts_barrier" ::: "memory")
#define ATT_WAITBAR_L() asm volatile("s_waitcnt lgkmcnt(0)\n\ts_barrier" ::: "memory")
__device__ __forceinline__ void glds16(const char* gbase, unsigned voff, unsigned lds_dst) { unsigned keep;
    asm volatile("s_mov_b32 %0, m0\n\ts_mov_b32 m0, %3\n\ts_nop 0\n\tglobal_load_lds_dwordx4 %1, %2\n\ts_mov_b32 m0, %0" : "=&s"(keep) : "v"(voff), "s"(gbase), "s"(lds_dst) : "memory"); }
#define MFMA32(a, b, c) __builtin_amdgcn_mfma_f32_32x32x16_bf16((a), (b), (c), 0, 0, 0)

#ifndef ATT_WAVESKIP
#define ATT_WAVESKIP 1
#endif
#ifndef ATT_REFINE
#define ATT_REFINE 1
#endif
#ifndef ATT_ROLE
#define ATT_ROLE(wv) (wv)
#endif
constexpr float SKIP_THR = 32.0f;
template <bool CHECK = false>
__device__ __forceinline__ void att_norms(Frame& F) {
    const bf16* P = WSP(bf16, WS_PROJ); float* NRM = WSP(float, WS_NRM);
    LAS float* red = (LAS float*)(F.lds + RING_OFF);
    for (int u = F.vcu; u < NB * 128; u += F.G) {
        const size_t row0 = (size_t)u * 64 + F.wave * 8;
        float mx[4] = {0.f, 0.f, 0.f, 0.f};
#pragma unroll 4
        for (int r = 0; r < 8; ++r) {
            const bf16* rp = P + (row0 + r) * PITCH + 8 * F.lane;
#pragma unroll
            for (int i = 0; i < 4; ++i) { const v4u v = *(const v4u*)(rp + 512 * i); float s = 0.f;
#pragma unroll
                for (int k = 0; k < 4; ++k) { const float a = bflo(v[k]), c = bfhi(v[k]); s += a * a + c * c; }
                s += __shfl_xor(s, 1); s += __shfl_xor(s, 2); s += __shfl_xor(s, 4);
                mx[i] = __builtin_fmaxf(mx[i], s); }
        }
        __syncthreads();
        if ((F.lane & 7) == 0) {
#pragma unroll
            for (int i = 0; i < 4; ++i) red[F.wave * 32 + 8 * i + (F.lane >> 3)] = mx[i]; }
        LDS_WAIT(); __syncthreads();
        if (F.tid < 32) { float m = 0.f;
#pragma unroll
            for (int w = 0; w < 8; ++w) m = __builtin_fmaxf(m, red[w * 32 + F.tid]);
            if (CHECK) { const float t = NRM[(size_t)u * 32 + F.tid]; if (!(__builtin_fabsf(t - m) <= 1e-5f * m)) __hip_atomic_store(F.ctl + CW_CODE, 1u, RLX_AGENT); }
            else NRM[(size_t)u * 32 + F.tid] = m; }
    }
    __syncthreads();
}
struct FtLoads { float a[8], k[4]; };
__device__ __forceinline__ FtLoads att_ft_loads(Frame& F, int b, int h, int qb) {
    const float* NR = WSP(float, WS_NRM) + (size_t)b * 128 * 32;
    const int g0 = 2 * h;
    FtLoads L;
#pragma unroll
    for (int m = 0; m < 2; ++m) {
        L.a[4 * m + 0] = NR[(2 * qb) * 32 + g0 + m];      L.a[4 * m + 1] = NR[(2 * qb + 1) * 32 + g0 + m];
        L.a[4 * m + 2] = NR[(2 * qb) * 32 + 16 + g0 + m]; L.a[4 * m + 3] = NR[(2 * qb + 1) * 32 + 16 + g0 + m]; }
#pragma unroll
    for (int rd = 0; rd < 2; ++rd)
#pragma unroll
        for (int m = 0; m < 2; ++m) L.k[2 * rd + m] = NR[(rd * 64 + F.lane) * 32 + 16 + g0 + m];
    return L;
}
__device__ __forceinline__ int att_ft_eval(const FtLoads& L, Frame& F, int qb, float slope2) {
    float qn[2], kd[2];
#pragma unroll
    for (int m = 0; m < 2; ++m) {
        qn[m] = __builtin_sqrtf(__builtin_fmaxf(L.a[4 * m + 0], L.a[4 * m + 1]));
        kd[m] = __builtin_sqrtf(__builtin_fmaxf(L.a[4 * m + 2], L.a[4 * m + 3])); }
    int j0 = 2 * qb;
#pragma unroll
    for (int rd = 1; rd >= 0; --rd) {
        const int j = rd * 64 + F.lane; bool need = false;
        const float dmin = (float)(128 * qb - 64 * j - 63) * slope2;
#pragma unroll
        for (int m = 0; m < 2; ++m) { const float kn = __builtin_sqrtf(L.k[2 * rd + m]); need = need || (qn[m] * (kn + kd[m]) + SKIP_THR > dmin); }
        need = need && (j < 2 * qb);
        const unsigned long long bal = __ballot(need);
        if (bal) j0 = rd * 64 + (int)__builtin_ctzll(bal);
    }
    return j0;
}

__device__ __forceinline__ int att_ft_eval2(const FtLoads& L, Frame& F, int qb, float slope2, const float (&mmin)[2]) {
    float qn[2];
#pragma unroll
    for (int m = 0; m < 2; ++m) qn[m] = __builtin_sqrtf(__builtin_fmaxf(L.a[4 * m + 0], L.a[4 * m + 1]));
    int j0 = 2 * qb;
#pragma unroll
    for (int rd = 1; rd >= 0; --rd) {
        const int j = rd * 64 + F.lane; bool need = false;
        const float dmin = (float)(128 * qb - 64 * j - 63) * slope2;
#pragma unroll
        for (int m = 0; m < 2; ++m) { const float kn = __builtin_sqrtf(L.k[2 * rd + m]); need = need || (qn[m] * kn - mmin[m] + SKIP_THR > dmin); }
        need = need && (j < 2 * qb);
        const unsigned long long bal = __ballot(need);
        if (bal) j0 = rd * 64 + (int)__builtin_ctzll(bal);
    }
    return j0;
}

struct SteadyArgs { LAS const unsigned char* citab; unsigned kb, vb; float base, base1; bf16x8 q[4]; };
template <int MODE>
__device__ __forceinline__ void att_steady(const SteadyArgs& a, f32x16 (&o)[4], f32x16& c0, f32x16& c1, f32x16& n0, f32x16& n1, v4u (&pw)[4],
                                           float& m_cur, float& al_out, float& ls_out, bool& pv_on) {
#define SB_() __builtin_amdgcn_sched_barrier(0)
#define LP_(x) ((LAS const unsigned char*)(uintptr_t)(x))
#define KF0_(d0) (*(LAS const bf16x8*)(LP_(a.kb ^ (32u * (d0)))))
#define KF1_(d0) (*(LAS const bf16x8*)(LP_(a.kb ^ (32u * (d0))) + 4096))
#define QF_(d0) (a.q[d0])
#define VF_(d, s) __builtin_shufflevector(lds_tr16(LP_(a.vb ^ (64u * (d))) + (s) * 4096), lds_tr16(LP_(a.vb ^ (64u * (d)) ^ 2080u) + (s) * 4096), 0, 1, 2, 3, 4, 5, 6, 7)
#define PVM_(slot, vf) o[(slot) & 3] = MFMA32(vf, __builtin_bit_cast(bf16x8, pw[(slot) >> 2]), o[(slot) & 3])
#define MX_(b) do { mx0 = __builtin_fmaxf(__builtin_fmaxf(mx0, c0[b]), c0[(b) + 1]); mx0 = __builtin_fmaxf(__builtin_fmaxf(mx0, c0[(b) + 2]), c0[(b) + 3]); \
                     mx1 = __builtin_fmaxf(__builtin_fmaxf(mx1, c1[b]), c1[(b) + 1]); mx1 = __builtin_fmaxf(__builtin_fmaxf(mx1, c1[(b) + 2]), c1[(b) + 3]); } while (0)
#define MXROW_() do { float mx = __builtin_fmaxf(mx0 + a.base, mx1 + a.base1); \
      auto rr = __builtin_amdgcn_permlane32_swap(__float_as_uint(mx), __float_as_uint(mx), false, false); mxr = __builtin_fmaxf(__uint_as_float(rr[0]), __uint_as_float(rr[1])); } while (0)
#define CINIT_() do { const f32x4 t0 = *(LAS const f32x4*)(a.citab), t1 = *(LAS const f32x4*)(a.citab + 16), t2 = *(LAS const f32x4*)(a.citab + 32), t3 = *(LAS const f32x4*)(a.citab + 48); \
      n0 = (f32x16){t0.x, t0.y, t0.z, t0.w, t1.x, t1.y, t1.z, t1.w, t2.x, t2.y, t2.z, t2.w, t3.x, t3.y, t3.z, t3.w}; } while (0)
    float mx0 = -1e30f, mx1 = -1e30f, mxr;
    if (pv_on) {
    bf16x8 v0_ = VF_(0, 0), v1_ = VF_(1, 0);
    SB_();
    bf16x8 v2_ = VF_(2, 0), v3_ = VF_(3, 0), v4_ = VF_(0, 1);
    PVM_(0, v0_); PVM_(1, v1_); PVM_(2, v2_);
    MX_(0); MX_(4);
    SB_();
    bf16x8 v5_ = VF_(1, 1), v6_ = VF_(2, 1), v7_ = VF_(3, 1);
    PVM_(3, v3_); PVM_(4, v4_); PVM_(5, v5_);
    MX_(8); MX_(12);
    MXROW_();
    SB_();
    bf16x8 v8_ = VF_(0, 2), v9_ = VF_(1, 2), v10_ = VF_(2, 2);
    PVM_(6, v6_); PVM_(7, v7_); PVM_(8, v8_);
    SB_();
    bf16x8 v11_ = VF_(3, 2), v12_ = VF_(0, 3), v13_ = VF_(1, 3);
    PVM_(9, v9_); PVM_(10, v10_); PVM_(11, v11_);
    SB_();
    bf16x8 v14_ = VF_(2, 3), v15_ = VF_(3, 3), ka0 = KF0_(0), kb0 = KF1_(0), q0_ = QF_(0);
    PVM_(12, v12_); PVM_(13, v13_); PVM_(14, v14_);
    SB_();
    CINIT_();
    bf16x8 ka1 = KF0_(1), kb1 = KF1_(1), q1_ = QF_(1);
    PVM_(15, v15_); n1 = MFMA32(kb0, q0_, n0); n0 = MFMA32(ka0, q0_, n0);
    SB_();
    bf16x8 ka2 = KF0_(2), q2_ = QF_(2);
    n0 = MFMA32(ka1, q1_, n0); n1 = MFMA32(kb1, q1_, n1);
    SB_();
    bf16x8 kb2 = KF1_(2), ka3 = KF0_(3), q3_ = QF_(3);
    n0 = MFMA32(ka2, q2_, n0);
    SB_();
    bf16x8 kb3 = KF1_(3);
    n1 = MFMA32(kb2, q2_, n1); n0 = MFMA32(ka3, q3_, n0); n1 = MFMA32(kb3, q3_, n1);
    SB_();
    } else {
    bf16x8 ka0 = KF0_(0), kb0 = KF1_(0), q0_ = QF_(0);
    CINIT_();
    SB_();
    bf16x8 ka1 = KF0_(1), kb1 = KF1_(1), q1_ = QF_(1);
    n1 = MFMA32(kb0, q0_, n0); n0 = MFMA32(ka0, q0_, n0);
    MX_(0); MX_(4);
    SB_();
    bf16x8 ka2 = KF0_(2), kb2 = KF1_(2), q2_ = QF_(2);
    n0 = MFMA32(ka1, q1_, n0); n1 = MFMA32(kb1, q1_, n1);
    MX_(8); MX_(12);
    MXROW_();
    SB_();
    bf16x8 ka3 = KF0_(3), kb3 = KF1_(3), q3_ = QF_(3);
    n0 = MFMA32(ka2, q2_, n0); n1 = MFMA32(kb2, q2_, n1);
    SB_();
    n0 = MFMA32(ka3, q3_, n0); n1 = MFMA32(kb3, q3_, n1);
    SB_();
    }
    const bool ex_on = !ATT_WAVESKIP || __any(mxr > m_cur - SKIP_THR);
    f32x2 ls2 = {0.f, 0.f};
    if (ex_on) {
    const float mnew = __builtin_fmaxf(m_cur, mxr); al_out = __builtin_amdgcn_exp2f(m_cur - mnew); m_cur = mnew;
    const float sh = a.base - mnew, sh1 = a.base1 - mnew;
    const f32x2 sh2 = {sh, sh}, sh12 = {sh1, sh1};
#pragma unroll
    for (int r = 0; r < 16; r += 2) {
        f32x2 t = (f32x2){c0[r], c0[r + 1]} + sh2;
        t.x = __builtin_amdgcn_exp2f(t.x); t.y = __builtin_amdgcn_exp2f(t.y);
        ls2 += t; c0[r] = t.x; c0[r + 1] = t.y;
    }
#pragma unroll
    for (int r = 0; r < 16; r += 2) {
        f32x2 t = (f32x2){c1[r], c1[r + 1]} + sh12;
        t.x = __builtin_amdgcn_exp2f(t.x); t.y = __builtin_amdgcn_exp2f(t.y);
        ls2 += t; c1[r] = t.x; c1[r + 1] = t.y;
    }
    pw[0] = (v4u){cvtpk(c0[0], c0[1]), cvtpk(c0[2], c0[3]), cvtpk(c0[4], c0[5]), cvtpk(c0[6], c0[7])};
    pw[1] = (v4u){cvtpk(c0[8], c0[9]), cvtpk(c0[10], c0[11]), cvtpk(c0[12], c0[13]), cvtpk(c0[14], c0[15])};
    pw[2] = (v4u){cvtpk(c1[0], c1[1]), cvtpk(c1[2], c1[3]), cvtpk(c1[4], c1[5]), cvtpk(c1[6], c1[7])};
    pw[3] = (v4u){cvtpk(c1[8], c1[9]), cvtpk(c1[10], c1[11]), cvtpk(c1[12], c1[13]), cvtpk(c1[14], c1[15])};
    } else { al_out = 1.0f; }
    ls_out = ls2.x + ls2.y;
    pv_on = ex_on;
#undef SB_
#undef LP_
#undef KF0_
#undef KF1_
#undef QF_
#undef VF_
#undef PVM_
#undef MX_
#undef MXROW_
#undef CINIT_
}

template <int MODE = 0>
__device__ __forceinline__ void attn_unit(Frame& F, int b, int h, int qb, float lam) {
    int lane_ = F.lane; asm volatile("" : "+v"(lane_));
    const int lane = lane_, w = ATT_ROLE(F.wave), g = w >> 1, m = w & 1, r32 = lane & 31, hi = lane >> 5;
    const bf16* __restrict__ P = WSP(bf16, WS_PROJ);
    bf16* MIX = WSP(bf16, WS_XB);
    LAS unsigned char* lds = F.lds + RING_OFF;
    const size_t rowb = (size_t)b * SEQ;
    const int q0 = qb * 128;
    const int t = q0 + 32 * g + r32;
    const float slope2 = __builtin_amdgcn_exp2f(-(float)(h + 1)) * LOG2E;
    const int jmax = 2 * qb + 1, jw = 2 * qb + (g >> 1);
    const char* Pb = (const char*)(P + rowb * PITCH);
#define ATT_KOFFS() unsigned koffA, koffB; { int l_ = lane; asm volatile("" : "+v"(l_)); const int kr = 16 * (w >> 1) + (l_ >> 3), cp = l_ & 7;     \
      const int cA = cp ^ ((kr >> 1) & 7), cB = cp ^ (((kr + 8) >> 1) & 7); \
      koffA = (unsigned)(kr * PITCH + KC + h * 128 + (w & 1) * 64 + cA * 8) * 2u; koffB = (unsigned)((kr + 8) * PITCH + KC + h * 128 + (w & 1) * 64 + cB * 8) * 2u; }
#define ATT_VOFFS() unsigned voffA, voffB; { int l_ = lane; asm volatile("" : "+v"(l_)); const int vr = 8 * w + (l_ >> 4), vp = l_ & 15;                    \
      const int hA = vp ^ (((vr & 3) << 2) | ((vr >> 2) & 3)), hB = vp ^ ((((vr + 4) & 3) << 2) | (((vr + 4) >> 2) & 3)); \
      voffA = (unsigned)(vr * PITCH + VC + h * 128 + hA * 8) * 2u; voffB = (unsigned)((vr + 4) * PITCH + VC + h * 128 + hB * 8) * 2u; }
    const unsigned lds0 = (unsigned)(uintptr_t)lds;
    const unsigned kdst = lds0 + (unsigned)((w & 1) * 8192 + (w >> 1) * 2048), vdst = lds0 + 49152u + (unsigned)(w * 2048);
#define ATT_DMA_K(k) do { if (MODE == 2) break; ATT_KOFFS() const char* tb_ = Pb + (size_t)(jmax - (k)) * (64 * PITCH * 2); const unsigned so_ = (unsigned)((k) % 3) * 16384u; \
        glds16(tb_, koffA, kdst + so_); glds16(tb_, koffB, kdst + so_ + 1024u); } while (0)
#define ATT_DMA_V(k) do { if (MODE == 2) break; ATT_VOFFS() const char* tb_ = Pb + (size_t)(jmax - (k)) * (64 * PITCH * 2); const unsigned so_ = (unsigned)((k) % 3) * 16384u; \
        glds16(tb_, voffA, vdst + so_); glds16(tb_, voffB, vdst + so_ + 1024u); } while (0)
    ATT_DMA_K(0);
    ATT_DMA_K(1);
    LAS unsigned char* qlds = lds + 98304 + w * 4096 + lane * 16;
    int NT_full; FtLoads ftl;
    { const bf16* qp = P + (rowb + t) * PITCH + QC + h * 128 + m * 64 + hi * 8;
      bf16x8 qtmp[4];
#pragma unroll
      for (int d0 = 0; d0 < 4; ++d0) qtmp[d0] = *(const bf16x8*)(qp + d0 * 16);
      ftl = att_ft_loads(F, b, h, qb);
#pragma unroll
      for (int d0 = 0; d0 < 4; ++d0) *(LAS bf16x8*)(qlds + d0 * 1024) = qtmp[d0];
      NT_full = jmax + 1 - att_ft_eval(ftl, F, qb, slope2); }
    int NT = (MODE == 7) ? 2 : NT_full;
    f32x16 o[4];
#pragma unroll
    for (int d = 0; d < 4; ++d)
#pragma unroll
        for (int r = 0; r < 16; ++r) o[d][r] = 0.f;
    LAS float* citab_w = (LAS float*)(F.lds + TAB_OFF + 2048);
    if (w == 0 && lane < 32) citab_w[lane] = slope2 * (float)(((lane & 15) & 3) + 8 * ((lane & 15) >> 2) + 4 * (lane >> 4));
    LAS const unsigned char* citab = (LAS const unsigned char*)citab_w + hi * 64;
    const float c32 = 32.f * slope2;
    float lrun = 0.f;
    const int vad0 = 256 * (4 * hi + ((lane & 15) >> 2)) + 16 * (((((lane & 15) >> 2)) << 2) | ((2 * ((lane >> 4) & 1) + ((lane & 3) >> 1)) ^ hi)) + 8 * (lane & 1);
    const int kad = 128 * r32 + 16 * (hi ^ ((r32 >> 1) & 7));
#define ATT_TOP(i) do { const int i_ = (i); const int cnt_ = 2 * ((i_ + 2) < NT) + 2 * ((i_ + 1) >= 1 && (i_ + 1) <= NT); \
        if (cnt_ == 4) { ATT_WAITBAR(4); } else if (cnt_ == 2) { ATT_WAITBAR(2); } else { ATT_WAITBAR(0); } \
        if (i_ + 3 < NT) ATT_DMA_K(i_ + 3); if (i_ + 1 >= 0 && i_ + 1 < NT) ATT_DMA_V(i_ + 1); } while (0)
#define ATT_SB() __builtin_amdgcn_sched_barrier(0)
#define ATT_LOADCI(dst) do { const f32x4 t0_ = *(LAS const f32x4*)(citab), t1_ = *(LAS const f32x4*)(citab + 16), t2_ = *(LAS const f32x4*)(citab + 32), t3_ = *(LAS const f32x4*)(citab + 48); \
        dst = (f32x16){t0_.x, t0_.y, t0_.z, t0_.w, t1_.x, t1_.y, t1_.z, t1_.w, t2_.x, t2_.y, t2_.z, t2_.w, t3_.x, t3_.y, t3_.z, t3_.w}; } while (0)
#define ATT_QKG(k, DIAG, d0_, d1_) do { LAS const unsigned char* Kb = lds + ((k) % 3) * 16384 + m * 8192; \
        if (DIAG) { d0_ = zero16; d1_ = zero16; } else { ATT_LOADCI(d0_); ATT_LOADCI(d1_); } \
        _Pragma("unroll") for (int d0 = 0; d0 < 4; ++d0) { const bf16x8 kf0 = *(LAS const bf16x8*)(Kb + (kad ^ (32 * d0))), kf1 = *(LAS const bf16x8*)(Kb + (kad ^ (32 * d0)) + 4096), qf = *(LAS const bf16x8*)(qlds + d0 * 1024); \
            d0_ = MFMA32(kf0, qf, d0_); d1_ = MFMA32(kf1, qf, d1_); } } while (0)
#define ATT_PVG(kv, pw_) do { LAS const unsigned char* Vb = lds + 49152 + ((kv) % 3) * 16384; \
        _Pragma("unroll") for (int d = 0; d < 4; ++d) { _Pragma("unroll") for (int s = 0; s < 4; ++s) { \
            const s16x4 lo = lds_tr16(Vb + (vad0 ^ (64 * d)) + s * 4096); const s16x4 hh = lds_tr16(Vb + (vad0 ^ (64 * d) ^ 2080) + s * 4096); \
            o[d] = MFMA32(__builtin_shufflevector(lo, hh, 0, 1, 2, 3, 4, 5, 6, 7), __builtin_bit_cast(bf16x8, pw_[s]), o[d]); } ATT_SB(); } } while (0)
#define ATT_STAGEA(k, DIAG, x0_, x1_) do { const int j = jmax - (k); const int lb = 64 * j - t; float base = 0.f, base1 = 0.f; \
        if (DIAG) { const float lbf = (float)(lb + 4 * hi); \
            _Pragma("unroll") for (int r = 0; r < 16; ++r) { const float off = (float)((r & 3) + 8 * (r >> 2)); \
                x0_[r] = __builtin_fmaf(-slope2, __builtin_fabsf(lbf + off), x0_[r]); x1_[r] = __builtin_fmaf(-slope2, __builtin_fabsf(lbf + off + 32.f), x1_[r]); } } \
        else { base = slope2 * (float)lb; base1 = base + c32; } \
        float mx0 = -1e30f, mx1 = -1e30f; \
        _Pragma("unroll") for (int r = 0; r < 16; ++r) { mx0 = __builtin_fmaxf(mx0, x0_[r]); mx1 = __builtin_fmaxf(mx1, x1_[r]); } \
        float mx = __builtin_fmaxf(mx0 + base, mx1 + base1); \
        { auto rr = __builtin_amdgcn_permlane32_swap(__float_as_uint(mx), __float_as_uint(mx), false, false); mx = __builtin_fmaxf(__uint_as_float(rr[0]), __uint_as_float(rr[1])); } \
        const float mnew = __builtin_fmaxf(m_cur, mx); al_cur = __builtin_amdgcn_exp2f(m_cur - mnew); m_cur = mnew; sh_cur = base - mnew; sh1_cur = base1 - mnew; } while (0)
#define ATT_STAGEB(x0_, x1_, pw_) do { float ls = 0.f; \
        _Pragma("unroll") for (int r = 0; r < 16; ++r) { x0_[r] = __builtin_amdgcn_exp2f(x0_[r] + sh_cur); x1_[r] = __builtin_amdgcn_exp2f(x1_[r] + sh1_cur); ls += x0_[r] + x1_[r]; } \
        pw_[0] = (v4u){cvtpk(x0_[0], x0_[1]), cvtpk(x0_[2], x0_[3]), cvtpk(x0_[4], x0_[5]), cvtpk(x0_[6], x0_[7])}; \
        pw_[1] = (v4u){cvtpk(x0_[8], x0_[9]), cvtpk(x0_[10], x0_[11]), cvtpk(x0_[12], x0_[13]), cvtpk(x0_[14], x0_[15])}; \
        pw_[2] = (v4u){cvtpk(x1_[0], x1_[1]), cvtpk(x1_[2], x1_[3]), cvtpk(x1_[4], x1_[5]), cvtpk(x1_[6], x1_[7])}; \
        pw_[3] = (v4u){cvtpk(x1_[8], x1_[9]), cvtpk(x1_[10], x1_[11]), cvtpk(x1_[12], x1_[13]), cvtpk(x1_[14], x1_[15])}; \
        lrun = lrun * al_cur + ls; ATT_RESCALE(); } while (0)
#define ATT_RESCALE() do { if (__any(al_cur != 1.0f)) { _Pragma("unroll") for (int d = 0; d < 4; ++d) _Pragma("unroll") for (int r = 0; r < 16; ++r) o[d][r] *= al_cur; } } while (0)
    f32x16 zero16;
#pragma unroll
    for (int r = 0; r < 16; ++r) zero16[r] = 0.f;
    f32x16 sA0, sA1, sB0, sB1; v4u pwB[4];
    float m_cur = -1e30f, al_cur = 1.0f, sh_cur = 0.f, sh1_cur = 0.f;
    const bool act0 = (jmax <= jw);
    if (MODE == 0 || MODE >= 7) {
    ATT_TOP(-1); if (act0) ATT_QKG(0, true, sA0, sA1);
    ATT_TOP(0);  if (act0) { ATT_QKG(1, false, sB0, sB1); } else { ATT_QKG(1, true, sB0, sB1); }
                 if (act0) { ATT_STAGEA(0, true, sA0, sA1); ATT_STAGEB(sA0, sA1, pwB); }
    ATT_TOP(1);  if (act0) ATT_PVG(0, pwB);
                 if (2 < NT) ATT_QKG(2, false, sA0, sA1);
                 if (act0) { ATT_STAGEA(1, false, sB0, sB1); } else { ATT_STAGEA(1, true, sB0, sB1); }
                 ATT_STAGEB(sB0, sB1, pwB);
    if (ATT_REFINE && NT > 3) {
        float wm = m_cur;
#pragma unroll
        for (int o_ = 1; o_ < 64; o_ <<= 1) wm = __builtin_fminf(wm, __shfl_xor(wm, o_));
        LAS float* exm = (LAS float*)(F.lds + TAB_OFF + 2048 + 256);
        if (lane == 0) exm[w] = wm;
        ATT_WAITBAR_L();
        float mmin[2];
        mmin[0] = __builtin_fminf(__builtin_fminf(exm[0], exm[2]), __builtin_fminf(exm[4], exm[6]));
        mmin[1] = __builtin_fminf(__builtin_fminf(exm[1], exm[3]), __builtin_fminf(exm[5], exm[7]));
        const int nt2 = jmax + 1 - att_ft_eval2(ftl, F, qb, slope2, mmin);
        NT = nt2 < 3 ? 3 : (nt2 < NT ? nt2 : NT);
    }
    int i = 2;
    bool pv_on = true;
    SteadyArgs sa; sa.citab = citab;
#pragma unroll
    for (int d0 = 0; d0 < 4; ++d0) sa.q[d0] = *(LAS const bf16x8*)(qlds + d0 * 1024);
#define ATT_STEADY(i_, C0, C1, N0, N1, PW) do { const int ii = (i_); \
        { unsigned kb_ = lds0 + (unsigned)(((ii + 1) % 3) * 16384 + m * 8192 + kad), vb_ = lds0 + 49152u + (unsigned)(((ii - 1) % 3) * 16384 + vad0); \
          asm volatile("" : "+v"(kb_), "+v"(vb_)); sa.kb = kb_; sa.vb = vb_; } \
        sa.base = slope2 * (float)(64 * (jmax - ii) - t); sa.base1 = sa.base + c32; \
        float ls_; att_steady<MODE>(sa, o, C0, C1, N0, N1, PW, m_cur, al_cur, ls_, pv_on); \
        lrun = lrun * al_cur + ls_; ATT_RESCALE(); } while (0)
    for (; i <= NT - 2; ++i) { ATT_TOP(i); ATT_STEADY(i, sA0, sA1, sB0, sB1, pwB); sA0 = sB0; sA1 = sB1; }
    if (NT >= 3) { ATT_TOP(NT - 1); if (pv_on) ATT_PVG(NT - 2, pwB); ATT_STAGEA(NT - 1, false, sA0, sA1); ATT_STAGEB(sA0, sA1, pwB); ATT_TOP(NT); ATT_PVG(NT - 1, pwB); }
    else { ATT_TOP(2); ATT_PVG(1, pwB); }
    }
    float mrun = m_cur; (void)mrun;
#undef ATT_TOP
#undef ATT_SB
#undef ATT_LOADCI
#undef ATT_QKG
#undef ATT_PVG
#undef ATT_STAGEA
#undef ATT_STAGEB
#undef ATT_RESCALE
#undef ATT_STEADY
    { auto rr = __builtin_amdgcn_permlane32_swap(__float_as_uint(lrun), __float_as_uint(lrun), false, false); lrun = __uint_as_float(rr[0]) + __uint_as_float(rr[1]); }
    const float inv = 1.0f / lrun;
    ATT_WAITBAR(0);
    int lane2 = lane; asm volatile("" : "+v"(lane2));
    const int hi2 = lane2 >> 5, t2 = q0 + 32 * g + (lane2 & 31);
    LAS float* ex = (LAS float*)(lds + g * 16384) + lane2;
    if (m == 1) {
#pragma unroll
        for (int d = 0; d < 4; ++d)
#pragma unroll
            for (int r = 0; r < 16; ++r) ex[(d * 16 + r) * 64] = o[d][r] * inv;
    }
    ATT_WAITBAR(0);
    if (m == 0) {
        float ss = 0.f;
#pragma unroll
        for (int d = 0; d < 4; ++d) {
#pragma unroll
            for (int r = 0; r < 16; ++r) { const float v = o[d][r] * inv - lam * ex[(d * 16 + r) * 64]; o[d][r] = v; ss += v * v; }
            __builtin_amdgcn_sched_barrier(0);
        }
        { auto rr = __builtin_amdgcn_permlane32_swap(__float_as_uint(ss), __float_as_uint(ss), false, false); ss = __uint_as_float(rr[0]) + __uint_as_float(rr[1]); }
        const float rs = 0.8f / __builtin_sqrtf(ss * (1.0f / 128.0f) + RMS_EPS);
        const float* nw = F.in[6] + 4 * hi2;
        bf16* orow = MIX + (rowb + t2) * DM + h * 128 + 4 * hi2;
#pragma unroll
        for (int d = 0; d < 4; ++d) {
#pragma unroll
            for (int gq = 0; gq < 4; ++gq) {
                const int dc = 32 * d + 8 * gq;
                const f32x4 nv = *(const f32x4*)(nw + dc);
                v2u ov; ov.x = cvtpk(o[d][4 * gq] * rs * nv.x, o[d][4 * gq + 1] * rs * nv.y); ov.y = cvtpk(o[d][4 * gq + 2] * rs * nv.z, o[d][4 * gq + 3] * rs * nv.w);
                if (MODE == 0) *(v2u*)(orow + dc) = ov;
            }
            __builtin_amdgcn_sched_barrier(0);
        }
    }
    ATT_WAITBAR(0);
#undef ATT_DMA_K
#undef ATT_KOFFS
#undef ATT_VOFFS
#undef ATT_DMA_V
}
}
namespace ssd {
#define MFMA16(a, b, c) __builtin_amdgcn_mfma_f32_16x16x32_bf16((a), (b), (c), 0, 0, 0)
constexpr int XT_P = 72;
constexpr int NAT_P = 136;
constexpr int L_TAB = 0;
constexpr int L_BT = 8192;
constexpr int L_CN = L_BT + 18432;
constexpr int L_XT = L_CN + 17408;
static_assert(L_XT + 8 * 9216 <= 131072, "ssd lds");

__device__ __forceinline__ float silu(float v) { return v * __builtin_amdgcn_rcpf(1.0f + __builtin_amdgcn_exp2f(-v * LOG2E)); }
__device__ __forceinline__ float softplus(float v) { return __builtin_fmaxf(v, 0.f) + log1pf(__expf(-__builtin_fabsf(v))); }

__device__ __forceinline__ float dt_tables(Frame& F, int b, int c, int g2) {
    const int hd = 8 * g2 + F.wave, l = F.lane;
    const float* DT = WSP(float, WS_DT);
    const float dtr = DT[((size_t)b * SEQ + 64 * c + l) * 16 + hd] + F.in[9][hd];
    const float dt = softplus(dtr);
    const float a = -__expf(F.in[10][hd]);
    float v = dt * a;
#pragma unroll
    for (int off = 1; off < 64; off <<= 1) { const float y = __shfl_up(v, off); if (l >= off) v += y; }
    LAS float* tab = (LAS float*)(F.lds + RING_OFF + L_TAB);
    const float tot = __shfl(v, 63);
    tab[F.wave * 64 + l] = dt; tab[512 + F.wave * 64 + l] = v; tab[1536 + F.wave * 64 + l] = dt * __expf(tot - v);
    return tot;
}

template <int NR> struct ConvIn { unsigned raw[NR + 3]; float w0[4], w1[4], b0, b1; };
template <int NR>
__device__ __forceinline__ void conv_load(Frame& F, int b, int c, int col, int l0, ConvIn<NR>& R) {
    const bf16* P = WSP(bf16, WS_PROJ);
    const float* cw = F.in[7]; const float* cb = F.in[8];
    const int cch = col - XC;
#pragma unroll
    for (int k = 0; k < 4; ++k) { R.w0[k] = cw[k * 1536 + cch]; R.w1[k] = cw[k * 1536 + cch + 1]; }
    R.b0 = cb[cch]; R.b1 = cb[cch + 1];
    const int tl0 = 64 * c + l0;
    const bf16* src = P + ((size_t)b * SEQ + tl0) * PITCH + col;
#pragma unroll
    for (int k = 0; k < 3; ++k) { R.raw[k] = 0u; if (tl0 - 3 + k >= 0) R.raw[k] = *(const unsigned*)(src + (ptrdiff_t)(k - 3) * PITCH); }
#pragma unroll
    for (int i = 0; i < NR; ++i) R.raw[3 + i] = *(const unsigned*)(src + (size_t)i * PITCH);
}
template <int NR, class Emit>
__device__ __forceinline__ void conv_run(const ConvIn<NR>& R, int l0, Emit&& emit) {
    float xa[3], xb_[3];
#pragma unroll
    for (int k = 0; k < 3; ++k) { xa[k] = bflo(R.raw[k]); xb_[k] = bfhi(R.raw[k]); }
#pragma unroll
    for (int i = 0; i < NR; ++i) {
        const float c0 = bflo(R.raw[3 + i]), c1 = bfhi(R.raw[3 + i]);
        const float y0 = R.b0 + R.w0[0] * xa[0] + R.w0[1] * xa[1] + R.w0[2] * xa[2] + R.w0[3] * c0;
        const float y1 = R.b1 + R.w1[0] * xb_[0] + R.w1[1] * xb_[1] + R.w1[2] * xb_[2] + R.w1[3] * c1;
        xa[0] = xa[1]; xa[1] = xa[2]; xa[2] = c0; xb_[0] = xb_[1]; xb_[1] = xb_[2]; xb_[2] = c1;
        emit(l0 + i, silu(y0), silu(y1));
    }
}

__device__ __forceinline__ void ssd_a_unit(Frame& F, int b, int c, int g2) {
    LAS unsigned char* lds = F.lds + RING_OFF;
    LAS float* tab = (LAS float*)(lds + L_TAB);
    int tid = F.tid; asm volatile("" : "+v"(tid));
    const int cp1 = tid % 320, l01 = (tid / 320) * 32;
    const int t2 = 512 + (tid & 127), cp2 = t2 % 320, l02 = (t2 / 320) * 32 + 8 * (tid >> 7);
    auto acol = [&](int cp) __attribute__((always_inline)) { return (cp < 256) ? XC + g2 * 512 + 2 * cp : XC + 1024 + g2 * 128 + 2 * (cp - 256); };
    ConvIn<32> R1; ConvIn<8> R2;
    conv_load<32>(F, b, c, acol(cp1), l01, R1); conv_load<8>(F, b, c, acol(cp2), l02, R2);
    const float tot = dt_tables(F, b, c, g2);
    if (F.lane == 63) WSP(float, WS_CD)[((size_t)b * 128 + c) * 16 + 8 * g2 + F.wave] = __expf(tot);
    LDS_WAIT(); __syncthreads();
    {
        unsigned* cvrow = (unsigned*)(WSP(bf16, WS_CONV) + ((size_t)b * SEQ + 64 * c) * 1280);
        auto run = [&](auto& R, int cp, int l0) __attribute__((always_inline)) {
            if (cp < 256) {
                const int ch = 2 * cp, hw = ch >> 6, p = ch & 63;
                LAS bf16* xt = (LAS bf16*)(lds + L_XT + hw * 9216);
                unsigned* cv = cvrow + (g2 * 512 + ch) / 2;
                conv_run(R, l0, [&](int l, float v0, float v1) {
                    const float sc = tab[1536 + hw * 64 + l];
                    cv[(size_t)l * 640] = pk2(v0, v1);
                    xt[p * XT_P + l] = (bf16)f2bf(v0 * sc); xt[(p + 1) * XT_P + l] = (bf16)f2bf(v1 * sc); });
            } else {
                const int n = 2 * (cp - 256);
                LAS bf16* bt = (LAS bf16*)(lds + L_BT);
                unsigned* cv = cvrow + (1024 + g2 * 128 + n) / 2;
                conv_run(R, l0, [&](int l, float v0, float v1) { const unsigned pk = pk2(v0, v1); cv[(size_t)l * 640] = pk; bt[n * XT_P + l] = (bf16)(pk & 0xffffu); bt[(n + 1) * XT_P + l] = (bf16)(pk >> 16); });
            }
        };
        __builtin_amdgcn_sched_barrier(0);
        run(R1, cp1, l01);
        __builtin_amdgcn_sched_barrier(0);
        run(R2, cp2, l02);
    }
    LDS_WAIT(); __syncthreads();
    {
        const int r = F.lane & 15, kq = F.lane >> 4, hd = 8 * g2 + F.wave;
        LAS const unsigned char* bt = lds + L_BT + (r * XT_P + 8 * kq) * 2;
        LAS const unsigned char* xt = lds + L_XT + F.wave * 9216 + (r * XT_P + 8 * kq) * 2;
        bf16* ST = (bf16*)F.out + ((((size_t)b * 128 + c) * 16 + hd) * 64) * 128;
#pragma unroll
        for (int nh = 0; nh < 2; ++nh) {
            f32x4 acc[4][4];
#pragma unroll
            for (int i = 0; i < 4; ++i)
#pragma unroll
                for (int j = 0; j < 4; ++j) acc[i][j] = (f32x4){0.f, 0.f, 0.f, 0.f};
#pragma unroll
            for (int ks = 0; ks < 2; ++ks) {
                bf16x8 af[4], bf_[4];
#pragma unroll
                for (int i = 0; i < 4; ++i) { af[i] = *(LAS const bf16x8*)(bt + ((nh * 4 + i) * 16 * XT_P + 32 * ks) * 2); bf_[i] = *(LAS const bf16x8*)(xt + (i * 16 * XT_P + 32 * ks) * 2); }
#pragma unroll
                for (int i = 0; i < 4; ++i)
#pragma unroll
                    for (int j = 0; j < 4; ++j) acc[i][j] = MFMA16(af[i], bf_[j], acc[i][j]);
            }
#pragma unroll
            for (int i = 0; i < 4; ++i)
#pragma unroll
                for (int j = 0; j < 4; ++j) {
                    const int n = (nh * 4 + i) * 16 + 4 * kq, p = 16 * j + r;
                    v2u o; o.x = pk2(acc[i][j].x, acc[i][j].y); o.y = pk2(acc[i][j].z, acc[i][j].w);
                    *(v2u*)(ST + (size_t)p * 128 + n) = o;
                }
        }
    }
    LDS_WAIT(); __syncthreads();
}

__device__ __forceinline__ void ssd_b_item(Frame& F, int item, size_t st_off = 0) {
    bf16* ST = (bf16*)F.out + st_off; const float* CD = WSP(float, WS_CD);
    static_assert(NB * 16 * 64 * 32 == 256 * NWAVES * 64, "ssd_b items");
    {
        const int gid = item * (NWAVES * 64) + F.tid;
        const int n4 = gid & 31, p = (gid >> 5) & 63, hd = (gid >> 11) & 15, b = gid >> 15;
        bf16* ptr = ST + ((((size_t)b * 128) * 16 + hd) * 64 + p) * 128 + 4 * n4;
        const float* cd = CD + (size_t)b * 128 * 16 + hd;
        float h0 = 0.f, h1 = 0.f, h2 = 0.f, h3 = 0.f;
#pragma unroll 16
        for (int c = 0; c < 128; ++c) {
            v2u* q = (v2u*)(ptr + (size_t)c * (16 * 64 * 128));
            const v2u v = *q; const float d = cd[c * 16];
            v2u o; o.x = pk2(h0, h1); o.y = pk2(h2, h3); *q = o;
            h0 = h0 * d + bflo(v.x); h1 = h1 * d + bfhi(v.x); h2 = h2 * d + bflo(v.y); h3 = h3 * d + bfhi(v.y);
        }
    }
}
__device__ __forceinline__ void ssd_b_queue(Frame& F) {
    volatile LAS unsigned* slot = F.MISC + 18;
    for (;;) {
        __syncthreads();
        if (F.tid == 0) *slot = __hip_atomic_fetch_add(F.ctl + CW_SBQ, 1u, RLX_AGENT);
        __syncthreads();
        const unsigned it = *slot;
        if (it >= 256u) break;
        ssd_b_item(F, (int)it);
        VM_WAIT(); __syncthreads();
        if (F.tid == 0) { __builtin_amdgcn_fence(__ATOMIC_RELEASE, "agent"); (void)__hip_atomic_fetch_add(F.ctl + CW_SBDONE, 1u, RLX_AGENT); }
    }
}

__device__ __forceinline__ void ssd_c_unit(Frame& F, int b, int c, int g2) {
    LAS unsigned char* lds = F.lds + RING_OFF;
    LAS float* tab = (LAS float*)(lds + L_TAB);
    int tid = F.tid; asm volatile("" : "+v"(tid));
    const int cp1 = tid % 320, l01 = (tid / 320) * 32;
    const int t2 = 512 + (tid & 127), cp2 = t2 % 320, l02 = (t2 / 320) * 32 + 8 * (tid >> 7);
    const int cpc = tid & 63, l0c = 32 * ((tid >> 6) & 1) + 8 * (tid >> 7);
    auto cch = [&](int cp) __attribute__((always_inline)) { return (cp < 256) ? g2 * 512 + 2 * cp : 1024 + g2 * 128 + 2 * (cp - 256); };
    const unsigned* cvrow = (const unsigned*)(WSP(bf16, WS_CONV) + ((size_t)b * SEQ + 64 * c) * 1280);
    unsigned c1[32], c2[8];
    { const unsigned* s1 = cvrow + (size_t)l01 * 640 + cch(cp1) / 2; const unsigned* s2 = cvrow + (size_t)l02 * 640 + cch(cp2) / 2;
#pragma unroll
      for (int i = 0; i < 32; ++i) c1[i] = s1[(size_t)i * 640];
#pragma unroll
      for (int i = 0; i < 8; ++i) c2[i] = s2[(size_t)i * 640]; }
    ConvIn<8> R3;
    conv_load<8>(F, b, c, XC + 1280 + g2 * 128 + 2 * cpc, l0c, R3);
    (void)dt_tables(F, b, c, g2);
    LDS_WAIT(); __syncthreads();
    {
        auto place = [&](const unsigned* v, int nrow, int cp, int l0) __attribute__((always_inline)) {
            if (cp < 256) {
                const int ch = 2 * cp, hw = ch >> 6, p = ch & 63;
                LAS bf16* xt = (LAS bf16*)(lds + L_XT + hw * 9216);
                for (int i = 0; i < nrow; ++i) { const int l = l0 + i; const float sc = tab[hw * 64 + l];
                    xt[p * XT_P + l] = (bf16)f2bf(bflo(v[i]) * sc); xt[(p + 1) * XT_P + l] = (bf16)f2bf(bfhi(v[i]) * sc); }
            } else {
                const int n = 2 * (cp - 256);
                LAS unsigned* bn = (LAS unsigned*)(lds + L_BT);
                for (int i = 0; i < nrow; ++i) bn[((l0 + i) * NAT_P + n) >> 1] = v[i];
            }
        };
        __builtin_amdgcn_sched_barrier(0);
        if (cp1 < 256) {
#pragma unroll
            for (int i = 0; i < 32; ++i) { unsigned one[1] = {c1[i]}; place(one, 1, cp1, l01 + i); }
        } else {
#pragma unroll
            for (int i = 0; i < 32; ++i) { unsigned one[1] = {c1[i]}; place(one, 1, cp1, l01 + i); }
        }
        __builtin_amdgcn_sched_barrier(0);
#pragma unroll
        for (int i = 0; i < 8; ++i) { unsigned one[1] = {c2[i]}; place(one, 1, cp2, l02 + i); }
        __builtin_amdgcn_sched_barrier(0);
        { const int n = 2 * cpc; LAS unsigned* cn = (LAS unsigned*)(lds + L_CN);
          conv_run(R3, l0c, [&](int l, float v0, float v1) { cn[(l * NAT_P + n) >> 1] = pk2(v0, v1); }); }
    }
    LDS_WAIT(); __syncthreads();
    const int r = F.lane & 15, kq = F.lane >> 4, w = F.wave, hd = 8 * g2 + w;
    LAS const unsigned char* bnp = lds + L_BT + (r * NAT_P + 8 * kq) * 2;
    LAS const unsigned char* cnp = lds + L_CN + (r * NAT_P + 8 * kq) * 2;
    f32x4 cb[4][4];
#pragma unroll
    for (int i = 0; i < 4; ++i)
#pragma unroll
        for (int j = 0; j < 4; ++j) cb[i][j] = (f32x4){0.f, 0.f, 0.f, 0.f};
    f32x4 acc[4][4];
#pragma unroll
    for (int i = 0; i < 4; ++i)
#pragma unroll
        for (int j = 0; j < 4; ++j) acc[i][j] = (f32x4){0.f, 0.f, 0.f, 0.f};
    const bf16* PREV = (const bf16*)F.out + ((((size_t)b * 128 + c) * 16 + hd) * 64) * 128;
#pragma unroll
    for (int ks = 0; ks < 4; ++ks) {
        bf16x8 bfr[4], cfr[4], pfr[4];
#pragma unroll
        for (int i = 0; i < 4; ++i) { bfr[i] = *(LAS const bf16x8*)(bnp + (i * 16 * NAT_P + 32 * ks) * 2); cfr[i] = *(LAS const bf16x8*)(cnp + (i * 16 * NAT_P + 32 * ks) * 2);
            pfr[i] = *(const bf16x8*)(PREV + (size_t)(16 * i + r) * 128 + 32 * ks + 8 * kq); }
#pragma unroll
        for (int ts = 0; ts < 4; ++ts)
#pragma unroll
            for (int tl = 0; tl < 4; ++tl) { if (ts <= tl) cb[ts][tl] = MFMA16(bfr[ts], cfr[tl], cb[ts][tl]); }
#pragma unroll
        for (int tp = 0; tp < 4; ++tp)
#pragma unroll
            for (int tl = 0; tl < 4; ++tl) acc[tp][tl] = MFMA16(pfr[tp], cfr[tl], acc[tp][tl]);
    }
    float acl[4];
#pragma unroll
    for (int tl = 0; tl < 4; ++tl) acl[tl] = tab[512 + w * 64 + 16 * tl + r];
#pragma unroll
    for (int tp = 0; tp < 4; ++tp)
#pragma unroll
        for (int tl = 0; tl < 4; ++tl) { const float od = __expf(acl[tl]); acc[tp][tl] = acc[tp][tl] * od; }
    const float dsk = F.in[11][hd];
    bf16x8 mf[2][4];
#pragma unroll
    for (int tl = 0; tl < 4; ++tl)
#pragma unroll
        for (int u = 0; u < 2; ++u) {
            unsigned pk[4];
#pragma unroll
            for (int half = 0; half < 2; ++half) {
                const int ts = 2 * u + half; float mv[4];
#pragma unroll
                for (int rg = 0; rg < 4; ++rg) {
                    float val = 0.f;
                    if (ts <= tl) {
                        const int s = 16 * ts + 4 * kq + rg, l = 16 * tl + r;
                        const float as = tab[512 + w * 64 + s];
                        val = (s <= l) ? cb[ts][tl][rg] * __expf(acl[tl] - as) : 0.f;
                        if (s == l) val += dsk / tab[w * 64 + l];
                    }
                    mv[rg] = val;
                }
                pk[half * 2] = pk2(mv[0], mv[1]); pk[half * 2 + 1] = pk2(mv[2], mv[3]);
            }
            v4u t4 = {pk[0], pk[1], pk[2], pk[3]}; mf[u][tl] = __builtin_bit_cast(bf16x8, t4);
        }
    LAS const unsigned char* xtp = lds + L_XT + w * 9216 + (r * XT_P + 4 * kq) * 2;
#pragma unroll
    for (int u = 0; u < 2; ++u) {
        bf16x8 xf[4];
#pragma unroll
        for (int tp = 0; tp < 4; ++tp) { const v2u lo = *(LAS const v2u*)(xtp + (tp * 16 * XT_P + 32 * u) * 2); const v2u hi2 = *(LAS const v2u*)(xtp + (tp * 16 * XT_P + 32 * u + 16) * 2);
            v4u t4 = {lo.x, lo.y, hi2.x, hi2.y}; xf[tp] = __builtin_bit_cast(bf16x8, t4); }
#pragma unroll
        for (int tp = 0; tp < 4; ++tp)
#pragma unroll
            for (int tl = 0; tl < 4; ++tl) { if (2 * u <= tl) acc[tp][tl] = MFMA16(xf[tp], mf[u][tl], acc[tp][tl]); }
    }
    const bf16* P = WSP(bf16, WS_PROJ);
    float ssq[4] = {0.f, 0.f, 0.f, 0.f};
#pragma unroll
    for (int tl = 0; tl < 4; ++tl) {
        const size_t trow = (size_t)b * SEQ + 64 * c + 16 * tl + r;
#pragma unroll
        for (int tp = 0; tp < 4; ++tp) {
            const v2u zv = *(const v2u*)(P + trow * PITCH + ZC + hd * 64 + 16 * tp + 4 * kq);
            f32x4 y = acc[tp][tl];
            y.x *= silu(bflo(zv.x)); y.y *= silu(bfhi(zv.x)); y.z *= silu(bflo(zv.y)); y.w *= silu(bfhi(zv.y));
            acc[tp][tl] = y; ssq[tl] += y.x * y.x + y.y * y.y + y.z * y.z + y.w * y.w;
        }
    }
#pragma unroll
    for (int tl = 0; tl < 4; ++tl) { ssq[tl] += __shfl_xor(ssq[tl], 16); ssq[tl] += __shfl_xor(ssq[tl], 32); if (kq == 0) tab[1024 + w * 64 + 16 * tl + r] = ssq[tl]; }
    LDS_WAIT(); __syncthreads();
    bf16* MIX = WSP(bf16, WS_XB);
    const float* nw = F.in[12] + hd * 64;
#pragma unroll
    for (int tl = 0; tl < 4; ++tl) {
        float tot = 0.f;
#pragma unroll
        for (int ww = 0; ww < 8; ++ww) tot += tab[1024 + ww * 64 + 16 * tl + r];
        const float rs = 1.0f / __builtin_sqrtf(tot * (1.0f / 512.0f) + RMS_EPS);
        const size_t trow = (size_t)b * SEQ + 64 * c + 16 * tl + r;
#pragma unroll
        for (int tp = 0; tp < 4; ++tp) {
            const f32x4 nv = *(const f32x4*)(nw + 16 * tp + 4 * kq);
            const f32x4 y = acc[tp][tl];
            v2u o; o.x = pk2(y.x * rs * nv.x, y.y * rs * nv.y); o.y = pk2(y.z * rs * nv.z, y.w * rs * nv.w);
            *(v2u*)(MIX + trow * DM + 1024 + hd * 64 + 16 * tp + 4 * kq) = o;
        }
    }
    LDS_WAIT(); __syncthreads();
}
__device__ __forceinline__ void ssd_c_queue(Frame& F) {
    volatile LAS unsigned* slot = F.MISC + 19;
    if (F.tid == 0) {
        unsigned sp = 0u;
        while (__hip_atomic_load(F.ctl + CW_SBDONE, RLX_AGENT) < 256u) { __builtin_amdgcn_s_sleep(8); if (++sp > (1u << 22)) break; }
        __builtin_amdgcn_fence(__ATOMIC_ACQUIRE, "agent");
    }
    for (;;) {
        __syncthreads();
        if (F.tid == 0) *slot = __hip_atomic_fetch_add(F.ctl + CW_SCQ, 1u, RLX_AGENT);
        __syncthreads();
        const unsigned u = *slot;
        if (u >= (unsigned)(NB * 128 * 2)) break;
        ssd_c_unit(F, (int)(u >> 8), (int)((u >> 1) & 127u), (int)(u & 1u));
    }
}
}
using pg8::UnitP; using pg8::cvt_pk_bf16;
struct EpiProj {
    static constexpr bool PERM = true;
    bf16* O; float* NRM; LAS float* ex;
    __device__ __forceinline__ void operator()(const f32x4 (&acc)[2][2][4][2], const UnitP& u, int wr, int wc, int fr, int fq) const {
        const float sc = (u.aux < 4) ? QSCALE : 1.f;
        const bool nrm = u.aux < 8;
        const int row0 = u.row0 + wr * 64 + fr, col0 = u.col0 + wc * 32 + 8 * fq;
        const int wid = wr * 4 + wc;
#pragma unroll
        for (int ai = 0; ai < 2; ++ai)
#pragma unroll
            for (int m = 0; m < 4; ++m) { bf16* rowp = O + (size_t)(row0 + ai * 128 + m * 16) * PITCH + col0;
#pragma unroll
                for (int bj = 0; bj < 2; ++bj) { const f32x4 v0 = acc[ai][bj][m][0] * sc, v1 = acc[ai][bj][m][1] * sc;
                    v4u w; w.x = cvt_pk_bf16(v0[0], v0[1]); w.y = cvt_pk_bf16(v0[2], v0[3]); w.z = cvt_pk_bf16(v1[0], v1[1]); w.w = cvt_pk_bf16(v1[2], v1[3]);
                    *(v4u*)(rowp + bj * 128) = w;
                    if (nrm) { float s = 0.f;
#pragma unroll
                        for (int k = 0; k < 4; ++k) { const float a = bflo(w[k]), c = bfhi(w[k]); s += a * a + c * c; }
                        s += __shfl_xor(s, 16); s += __shfl_xor(s, 32);
                        if (fq == 0) ex[wid * 256 + ((ai * 2 + bj) * 4 + m) * 16 + fr] = s; } } }
        if (nrm) {
            LDS_WAIT(); __builtin_amdgcn_s_barrier();
            const int bj = wc & 1;
#pragma unroll
            for (int ai = 0; ai < 2; ++ai) {
                const int idx = ((ai * 2 + bj) * 4 + fq) * 16 + fr;
                float s = ex[wid * 256 + idx] + ex[(wid ^ 1) * 256 + idx];
#pragma unroll
                for (int o = 1; o < 64; o <<= 1) s = __builtin_fmaxf(s, __shfl_xor(s, o));
                if (fr == 0 && fq == 0) NRM[(size_t)(u.row0 / 64 + 2 * ai + wr) * 32 + u.col0 / 64 + 2 * bj + (wc >> 1)] = s;
            }
        }
    }
};
struct EpiRes {
    static constexpr bool PERM = true;
    const float* X; bf16* Y; f32x2* STAT;
    __device__ __forceinline__ void operator()(const f32x4 (&acc)[2][2][4][2], const UnitP& u, int wr, int wc, int fr, int fq) const {
        const int col0 = u.col0 + wc * 32 + 8 * fq;
#pragma unroll
        for (int ai = 0; ai < 2; ++ai)
#pragma unroll
            for (int m = 0; m < 4; ++m) { const int r = u.row0 + ai * 128 + wr * 64 + m * 16 + fr; const size_t off = (size_t)r * DM + col0; float s = 0.f, q = 0.f;
#pragma unroll
                for (int bj = 0; bj < 2; ++bj) {
                    const f32x4 x0 = *(const f32x4*)(X + off + bj * 128), x1 = *(const f32x4*)(X + off + bj * 128 + 4);
                    const f32x4 v0 = x0 * DN_ALPHA + acc[ai][bj][m][0], v1 = x1 * DN_ALPHA + acc[ai][bj][m][1];
                    v4u w; w.x = cvt_pk_bf16(v0[0], v0[1]); w.y = cvt_pk_bf16(v0[2], v0[3]); w.z = cvt_pk_bf16(v1[0], v1[1]); w.w = cvt_pk_bf16(v1[2], v1[3]);
                    *(v4u*)(Y + off + bj * 128) = w;
                    s += (v0.x + v0.y) + (v0.z + v0.w) + (v1.x + v1.y) + (v1.z + v1.w);
                    q += (v0.x * v0.x + v0.y * v0.y) + (v0.z * v0.z + v0.w * v0.w) + (v1.x * v1.x + v1.y * v1.y) + (v1.z * v1.z + v1.w * v1.w); }
                s += __shfl_xor(s, 16); s += __shfl_xor(s, 32); q += __shfl_xor(q, 16); q += __shfl_xor(q, 32);
                if (fq == 0) STAT[(size_t)r * 32 + u.aux * 4 + wc] = (f32x2){s, q}; }
    }
};
__device__ __forceinline__ float silu_f(float v) { return v * __builtin_amdgcn_rcpf(1.0f + __builtin_amdgcn_exp2f(-v * LOG2E)); }
struct EpiGU {
    static constexpr bool PERM = true;
    bf16* H;
    __device__ __forceinline__ void operator()(const f32x4 (&acc)[2][2][4][2], const UnitP& u, int wr, int wc, int fr, int fq) const {
        const int row0 = u.row0 + wr * 64 + fr, col0 = u.col0 + wc * 32 + 8 * fq;
#pragma unroll
        for (int ai = 0; ai < 2; ++ai)
#pragma unroll
            for (int m = 0; m < 4; ++m) { bf16* rowp = H + (size_t)(row0 + ai * 128 + m * 16) * EHID + col0;
                const f32x4 g0 = acc[ai][0][m][0], g1 = acc[ai][0][m][1], u0 = acc[ai][1][m][0], u1 = acc[ai][1][m][1];
                v4u w; w.x = cvt_pk_bf16(silu_f(g0[0]) * u0[0], silu_f(g0[1]) * u0[1]); w.y = cvt_pk_bf16(silu_f(g0[2]) * u0[2], silu_f(g0[3]) * u0[3]);
                w.z = cvt_pk_bf16(silu_f(g1[0]) * u1[0], silu_f(g1[1]) * u1[1]); w.w = cvt_pk_bf16(silu_f(g1[2]) * u1[2], silu_f(g1[3]) * u1[3]);
                *(v4u*)rowp = w; }
    }
};
struct EpiGU8 {
    static constexpr bool PERM = true;
    unsigned char* H;
    __device__ __forceinline__ void operator()(const f32x4 (&acc)[2][2][4][2], const UnitP& u, int wr, int wc, int fr, int fq) const {
        const int row0 = u.row0 + wr * 64 + fr, col0 = u.col0 + wc * 32 + 8 * fq;
#pragma unroll
        for (int ai = 0; ai < 2; ++ai)
#pragma unroll
            for (int m = 0; m < 4; ++m) { unsigned char* rowp = H + (size_t)(row0 + ai * 128 + m * 16) * EHID + col0;
                constexpr float ws = F8_UNSCALED ? (1.0f / 64.0f) : 1.0f;
                const f32x4 g0 = acc[ai][0][m][0] * ws, g1 = acc[ai][0][m][1] * ws, u0 = acc[ai][1][m][0] * ws, u1 = acc[ai][1][m][1] * ws;
                v2u w; w.x = pk4_fp8(silu_f(g0[0]) * u0[0], silu_f(g0[1]) * u0[1], silu_f(g0[2]) * u0[2], silu_f(g0[3]) * u0[3]);
                w.y = pk4_fp8(silu_f(g1[0]) * u1[0], silu_f(g1[1]) * u1[1], silu_f(g1[2]) * u1[2], silu_f(g1[3]) * u1[3]);
                if (H != nullptr) *(v2u*)rowp = w; else asm volatile("" :: "v"(w.x), "v"(w.y)); }
    }
};
constexpr float YM_SCALE = 8.0f;
struct EpiDown {
    static constexpr bool PERM = true;
    bf16* O;
    __device__ __forceinline__ void operator()(const f32x4 (&acc)[2][2][4][2], const UnitP& u, int wr, int wc, int fr, int fq) const {
        const int row0 = u.row0 + wr * 64 + fr, col0 = u.col0 + wc * 32 + 8 * fq;
#pragma unroll
        for (int ai = 0; ai < 2; ++ai)
#pragma unroll
            for (int m = 0; m < 4; ++m) {
#if MOE_F8
                unsigned char* rowp = (unsigned char*)O + (size_t)(row0 + ai * 128 + m * 16) * DM + col0;
#pragma unroll
                for (int bj = 0; bj < 2; ++bj) { constexpr float ys = F8_UNSCALED ? YM_SCALE / 64.0f : YM_SCALE; const f32x4 v0 = acc[ai][bj][m][0] * ys, v1 = acc[ai][bj][m][1] * ys;
                    v2u w; w.x = pk4_fp8(v0[0], v0[1], v0[2], v0[3]); w.y = pk4_fp8(v1[0], v1[1], v1[2], v1[3]); *(v2u*)(rowp + bj * 128) = w; }
#else
                bf16* rowp = O + (size_t)(row0 + ai * 128 + m * 16) * DM + col0;
#pragma unroll
                for (int bj = 0; bj < 2; ++bj) { const f32x4 v0 = acc[ai][bj][m][0], v1 = acc[ai][bj][m][1];
                    v4u w; w.x = cvt_pk_bf16(v0[0], v0[1]); w.y = cvt_pk_bf16(v0[2], v0[3]); w.z = cvt_pk_bf16(v1[0], v1[1]); w.w = cvt_pk_bf16(v1[2], v1[3]);
                    *(v4u*)(rowp + bj * 128) = w; }
#endif
            }
    }
};

__device__ __forceinline__ void moe_tables(Frame& F) {
    LAS int* ts = (LAS int*)(F.lds + TAB_OFF); LAS int* cn = ts + 40;
    __syncthreads();
    if (F.tid < NEXP) cn[F.tid] = (int)__hip_atomic_load(F.ctl + CW_CNT + 64 * F.tid, RLX_AGENT);
    __syncthreads();
    if (F.tid == 0) { int a = 0; for (int e = 0; e < NEXP; ++e) { ts[e] = a; a += (cn[e] + 255) >> 8; } ts[NEXP] = a; }
    __syncthreads();
}
__device__ __forceinline__ bool moe_locate(LAS const int* ts, int rt, int& e, int& first, int& cnt) {
    const int ln = (int)(threadIdx.x & 63u), l31 = ln & 31;
    const int te = ts[l31 + 1], tb = ts[l31], cn = ts[40 + l31];
    if (rt >= __builtin_amdgcn_readlane(te, 31)) return false;
    const unsigned long long bal = __ballot(ln < 32 && te <= rt);
    e = (int)__popcll(bal);
    first = __builtin_amdgcn_readlane(tb, e); cnt = __builtin_amdgcn_readlane(cn, e);
    return true;
}
struct GateUpSched {
    static constexpr bool RAGGED = true;
    const char* A; const char* W; const int* LIST; LAS const int* ts; int G, c; unsigned rowb; int wsh;
    __device__ __forceinline__ bool get(int i, UnitP& u, const int (&R)[2], const int (&C)[2]) const {
        const int L = i * G + c, rt = L >> 3, pn = L & 7;
        int e, first, cnt; if (!moe_locate(ts, rt, e, first, cnt)) return false;
        const int j = rt - first, nvalid = cnt - j * 256;
#pragma unroll
        for (int h = 0; h < 2; ++h)
#pragma unroll
            for (int i2 = 0; i2 < 2; ++i2) { const int r = h * 128 + R[i2]; int tok = 0; if (r < nvalid) tok = LIST[(size_t)e * 32768 + j * 256 + r]; u.ao[h][i2] = (unsigned)tok * rowb + (unsigned)C[i2] * 2u; }
        u.A = A; u.B = W + ((size_t)(e * 8 + pn) << wsh); u.row0 = rt * 256; u.col0 = pn * 128; u.aux = e; u.vr = nvalid;
        return true;
    }
};
struct DownSched {
    static constexpr bool RAGGED = true;
    const char* A; const char* W; LAS const int* ts; int G, c; unsigned rowb; int wsh;
    __device__ __forceinline__ bool get(int i, UnitP& u, const int (&R)[2], const int (&C)[2]) const {
        const int L = i * G + c, rt = L >> 3, pn = L & 7;
        int e, first, cnt; if (!moe_locate(ts, rt, e, first, cnt)) return false;
#pragma unroll
        for (int h = 0; h < 2; ++h)
#pragma unroll
            for (int i2 = 0; i2 < 2; ++i2) u.ao[h][i2] = (unsigned)(h * 128 + R[i2]) * rowb + (unsigned)C[i2] * 2u;
        u.A = A + (size_t)rt * 256 * rowb; u.B = W + ((size_t)(e * 8 + pn) << wsh); u.row0 = rt * 256; u.col0 = pn * 256; u.aux = e;
        u.vr = cnt - (rt - first) * 256;
        return true;
    }
};

__device__ __forceinline__ void ln1_router(Frame& F, int cw_cnt = CW_CNT, size_t list_off = WS_LIST, size_t rt_off = WS_RT) {
    LAS unsigned char* lds = F.lds + RING_OFF;
    constexpr int WP = 520;
    LAS bf16* wqh = (LAS bf16*)lds;
    LAS bf16* wql = (LAS bf16*)(lds + 48 * WP * 2);
    LAS float* scr = (LAS float*)(lds + 102400 + F.wave * 3200);
    LAS float* gbq = (LAS float*)(F.lds + 135168);
    const bf16* Y = WSP(bf16, WS_Y); const f32x2* STAT = WSP(f32x2, WS_STAT); const bf16* WRH = WSP(bf16, WS_WRT); const bf16* WRL = WRH + 48 * 2048;
    bf16* H1B = WSP(bf16, WS_H1B); int* LIST = WSP(int, list_off); unsigned* RT = WSP(unsigned, rt_off);
    const float* g1 = F.in[14]; const float* b1 = F.in[15];
    const int r = F.lane & 15, kq = F.lane >> 4;
    const int ngrp = T / 16, per_pass = F.G * NWAVES;
    LAS unsigned* lhist = (LAS unsigned*)(F.lds + TAB_OFF + 512); LAS unsigned* lbase = lhist + 32;
    for (int base = 0; base < ngrp; base += per_pass) {
        const int grp = base + F.vcu * NWAVES + F.wave; const bool valid = grp < ngrp;
        const int row = (valid ? grp : 0) * 16 + r;
        float mean, rstd;
        { float s = 0.f, q = 0.f;
#pragma unroll
          for (int i = 0; i < 8; ++i) { const f32x2 v = STAT[(size_t)row * 32 + kq * 8 + i]; s += v.x; q += v.y; }
          s += __shfl_xor(s, 16); s += __shfl_xor(s, 32); q += __shfl_xor(q, 16); q += __shfl_xor(q, 32);
          mean = s * (1.0f / DM); const float var = q * (1.0f / DM) - mean * mean; rstd = 1.0f / __builtin_sqrtf(__builtin_fmaxf(var, 0.f) + LN_EPS); }
        if (valid && kq == 0) WSP(f32x2, WS_MR)[row] = (f32x2){mean, rstd};
        f32x4 acc[3];
#pragma unroll
        for (int i = 0; i < 3; ++i) acc[i] = (f32x4){0.f, 0.f, 0.f, 0.f};
        v4u ybuf[2][8];
        { const bf16* yrow = Y + (size_t)row * DM + 16 * kq;
#pragma unroll
          for (int p = 0; p < 4; ++p) { ybuf[0][2 * p] = *(const v4u*)(yrow + 64 * p); ybuf[0][2 * p + 1] = *(const v4u*)(yrow + 64 * p + 8); } }
        v4u tq[12]; f32x4 gq = {0.f, 0.f, 0.f, 0.f};
        auto tq_load = [&](int q) __attribute__((always_inline)) {
            int tl_ = F.tid; asm volatile("" : "+v"(tl_));
#pragma unroll
            for (int k = 0; k < 12; ++k) { const int f = tl_ + k * (NWAVES * 64); const int hl = f / (48 * 64), rem = f % (48 * 64), col = rem >> 6, k8 = rem & 63;
                tq[k] = *(const v4u*)(WRH + (size_t)hl * 48 * 2048 + (size_t)col * 2048 + q * 512 + 8 * k8); }
            if (F.tid < 256) gq = *(const f32x4*)((F.tid < 128 ? g1 : b1) + q * 512 + (F.tid & 127) * 4);
        };
        auto tq_store = [&]() __attribute__((always_inline)) {
            int tl_ = F.tid; asm volatile("" : "+v"(tl_));
#pragma unroll
            for (int k = 0; k < 12; ++k) { const int f = tl_ + k * (NWAVES * 64); const int hl = f / (48 * 64), rem = f % (48 * 64), col = rem >> 6, k8 = rem & 63;
                *(LAS v4u*)((LAS bf16*)lds + hl * 48 * WP + col * WP + 8 * k8) = tq[k]; }
            if (F.tid < 256) *(LAS f32x4*)(gbq + (F.tid < 128 ? 0 : 512) + (F.tid & 127) * 4) = gq;
        };
        tq_load(0);
#pragma nounroll
        for (int qk = 0; qk < 4; ++qk) {
#pragma unroll
          for (int eh = 0; eh < 2; ++eh) {
            const int e8 = 2 * qk + eh;
            if (e8 < 7) { const bf16* yrow = Y + (size_t)row * DM + (e8 + 1) * 256 + 16 * kq;
#pragma unroll
              for (int p = 0; p < 4; ++p) { ybuf[(eh + 1) & 1][2 * p] = *(const v4u*)(yrow + 64 * p); ybuf[(eh + 1) & 1][2 * p + 1] = *(const v4u*)(yrow + 64 * p + 8); } }
            if (eh == 0) {
                __syncthreads();
                tq_store();
                if (qk < 3) tq_load(qk + 1);
                LDS_WAIT(); __syncthreads();
            }
            if (valid) {
                const int c0 = eh * 256;
                bf16* hrow = H1B + (size_t)row * DM + e8 * 256 + 16 * kq;
                unsigned char* h8row = WSP(unsigned char, WS_H1F8) + (size_t)row * DM + e8 * 256 + 16 * kq;
                LAS const float* gp = gbq + c0 + 16 * kq; LAS const float* bp = gbq + 512 + c0 + 16 * kq;
                LAS const bf16* whr = wqh + r * WP + c0 + 16 * kq; LAS const bf16* wlr = wql + r * WP + c0 + 16 * kq;
#pragma unroll
                for (int p = 0; p < 4; ++p) {
                    v4u hi8[2]; v2u f8[2];
#pragma unroll
                    for (int hf = 0; hf < 2; ++hf) {
                        const v4u yv = ybuf[eh][2 * p + hf];
                        const int co = 64 * p + 8 * hf;
                        const f32x4 y0 = {bflo(yv.x), bfhi(yv.x), bflo(yv.y), bfhi(yv.y)}, y1 = {bflo(yv.z), bfhi(yv.z), bflo(yv.w), bfhi(yv.w)};
                        const f32x4 ga = *(LAS const f32x4*)(gp + co), gb = *(LAS const f32x4*)(gp + co + 4), ba = *(LAS const f32x4*)(bp + co), bb = *(LAS const f32x4*)(bp + co + 4);
                        const f32x4 h0 = (y0 - mean) * rstd * ga + ba, h1 = (y1 - mean) * rstd * gb + bb;
                        v4u hi4, lo4;
                        hi4.x = cvt_pk_bf16(h0.x, h0.y); hi4.y = cvt_pk_bf16(h0.z, h0.w); hi4.z = cvt_pk_bf16(h1.x, h1.y); hi4.w = cvt_pk_bf16(h1.z, h1.w);
                        lo4.x = cvt_pk_bf16(h0.x - bflo(hi4.x), h0.y - bfhi(hi4.x)); lo4.y = cvt_pk_bf16(h0.z - bflo(hi4.y), h0.w - bfhi(hi4.y));
                        lo4.z = cvt_pk_bf16(h1.x - bflo(hi4.z), h1.y - bfhi(hi4.z)); lo4.w = cvt_pk_bf16(h1.z - bflo(hi4.w), h1.w - bfhi(hi4.w));
                        hi8[hf] = hi4;
#if MOE_F8
                        f8[hf].x = pk4_fp8(h0.x, h0.y, h0.z, h0.w); f8[hf].y = pk4_fp8(h1.x, h1.y, h1.z, h1.w);
#endif
                        const bf16x8 ah = __builtin_bit_cast(bf16x8, hi4), al = __builtin_bit_cast(bf16x8, lo4);
#pragma unroll
                        for (int tn = 0; tn < 3; ++tn) {
                            const bf16x8 wh = *(LAS const bf16x8*)(whr + tn * 16 * WP + co), wl = *(LAS const bf16x8*)(wlr + tn * 16 * WP + co);
                            acc[tn] = __builtin_amdgcn_mfma_f32_16x16x32_bf16(ah, wh, acc[tn], 0, 0, 0);
                            acc[tn] = __builtin_amdgcn_mfma_f32_16x16x32_bf16(al, wh, acc[tn], 0, 0, 0);
                            acc[tn] = __builtin_amdgcn_mfma_f32_16x16x32_bf16(ah, wl, acc[tn], 0, 0, 0); }
                    }
#if !MOE_F8
                    *(v4u*)(hrow + 64 * p) = hi8[0]; *(v4u*)(hrow + 64 * p + 8) = hi8[1];
#endif
#if MOE_F8
                    { v4u f16 = {f8[0].x, f8[0].y, f8[1].x, f8[1].y}; *(v4u*)(h8row + 64 * p) = f16; }
#endif
                }
            }
          }
        }
#pragma unroll
        for (int tn = 0; tn < 3; ++tn)
#pragma unroll
            for (int rg = 0; rg < 4; ++rg) scr[(4 * kq + rg) * 49 + 16 * tn + r] = acc[tn][rg];
        LDS_WAIT(); asm volatile("" ::: "memory");
        int e0 = 0, e1 = 0; unsigned lr0 = 0u, lr1 = 0u; float wt0 = 0.f, wt1 = 0.f;
        if (valid && F.lane < 16) {
            LAS const float* lr = scr + F.lane * 49;
            float gl[4]; float gm = -1e30f; int gi = 0;
#pragma unroll
            for (int i = 0; i < 4; ++i) { gl[i] = lr[i] + F.in[17][i]; if (gl[i] > gm) { gm = gl[i]; gi = i; } }
            float gs = 0.f;
#pragma unroll
            for (int i = 0; i < 4; ++i) gs += __expf(gl[i] - gm);
            const float gprob = 1.0f / gs;
            float el[8];
#pragma unroll
            for (int i = 0; i < 8; ++i) el[i] = lr[4 + 8 * gi + i] + F.in[19][gi * 8 + i];
            float m1 = -1e30f; int i1 = 0;
#pragma unroll
            for (int i = 0; i < 8; ++i) if (el[i] > m1) { m1 = el[i]; i1 = i; }
            float m2 = -1e30f; int i2 = 0;
#pragma unroll
            for (int i = 0; i < 8; ++i) if (i != i1 && el[i] > m2) { m2 = el[i]; i2 = i; }
            const float e2 = __expf(m2 - m1); const float w0 = gprob / (1.0f + e2), w1 = gprob * e2 / (1.0f + e2);
            e0 = gi * 8 + i1; e1 = gi * 8 + i2; wt0 = w0; wt1 = w1;
            lr0 = __hip_atomic_fetch_add(lhist + e0, 1u, __ATOMIC_RELAXED, __HIP_MEMORY_SCOPE_WORKGROUP);
            lr1 = __hip_atomic_fetch_add(lhist + e1, 1u, __ATOMIC_RELAXED, __HIP_MEMORY_SCOPE_WORKGROUP);
        }
        LDS_WAIT(); __syncthreads();
        if (F.tid < NEXP) { const unsigned c = lhist[F.tid]; unsigned gb = 0u; if (c) gb = __hip_atomic_fetch_add(F.ctl + cw_cnt + 64 * F.tid, c, RLX_AGENT);
            lbase[F.tid] = gb; lhist[F.tid] = 0u; }
        LDS_WAIT(); __syncthreads();
        if (valid && F.lane < 16) {
            const int tok = grp * 16 + F.lane;
            const unsigned r0 = lbase[e0] + lr0, r1 = lbase[e1] + lr1;
            LIST[(size_t)e0 * 32768 + r0] = tok; LIST[(size_t)e1 * 32768 + r1] = tok;
            v4u rec = {(unsigned)e0, r0, (unsigned)e1, r1}; *(v4u*)(RT + (size_t)tok * 8) = rec;
            v2u wr2 = {__float_as_uint(wt0), __float_as_uint(wt1)}; *(v2u*)(RT + (size_t)tok * 8 + 4) = wr2;
        }
    }
    __syncthreads();
}

struct FinRow { v4u hh[4]; v2u ya[4], yb[4]; float w0, w1; f32x2 mr; };
__device__ __forceinline__ void fin_issue(FinRow& R, const bf16* H1B, const f32x2* MR, const unsigned char* YM, LAS const int* ts, int row, const v4u& rec, const v2u& wr2, int lane) {
    const size_t s0 = (size_t)ts[rec.x & 31] * 256 + rec.y, s1 = (size_t)ts[rec.z & 31] * 256 + rec.w;
    R.w0 = __uint_as_float(wr2.x); R.w1 = __uint_as_float(wr2.y); R.mr = MR[row];
#pragma unroll
    for (int j = 0; j < 4; ++j) { const int c = 512 * j + 8 * lane;
        R.hh[j] = *(const v4u*)(H1B + (size_t)row * DM + c);
#if MOE_F8
        R.ya[j] = *(const v2u*)(YM + s0 * DM + c); R.yb[j] = *(const v2u*)(YM + s1 * DM + c);
#endif
    }
}
__device__ __forceinline__ void fin_reduce(const FinRow& R, float* out, LAS const float* gl, int row, int lane_in) {
    int lane = lane_in; asm volatile("" : "+v"(lane));
    typedef float f2 __attribute__((ext_vector_type(2)));
    float v[4][8]; float sum = 0.f;
    const float w0 = R.w0 * (1.0f / YM_SCALE), w1 = R.w1 * (1.0f / YM_SCALE);
#pragma unroll
    for (int j = 0; j < 4; ++j) {
        const int c8 = 512 * j + 8 * lane;
        const int p0 = ((2 * j) * 64 + lane) * 4, p1 = ((2 * j + 1) * 64 + lane) * 4;
        const f32x4 ga = *(LAS const f32x4*)(gl + p0), gb = *(LAS const f32x4*)(gl + p1), ba = *(LAS const f32x4*)(gl + 2048 + p0), bb = *(LAS const f32x4*)(gl + 2048 + p1);
        const float g1v[8] = {ga.x, ga.y, ga.z, ga.w, gb.x, gb.y, gb.z, gb.w}, b1v[8] = {ba.x, ba.y, ba.z, ba.w, bb.x, bb.y, bb.z, bb.w};
#pragma unroll
        for (int i = 0; i < 4; ++i) {
            const unsigned aw = (i < 2) ? R.ya[j].x : R.ya[j].y, bw = (i < 2) ? R.yb[j].x : R.yb[j].y;
            const f2 fa = (i & 1) ? __builtin_amdgcn_cvt_pk_f32_fp8((int)aw, true) : __builtin_amdgcn_cvt_pk_f32_fp8((int)aw, false);
            const f2 fb = (i & 1) ? __builtin_amdgcn_cvt_pk_f32_fp8((int)bw, true) : __builtin_amdgcn_cvt_pk_f32_fp8((int)bw, false);
            const float h1a = (bflo(R.hh[j][i]) - R.mr.x) * R.mr.y * g1v[2 * i] + b1v[2 * i], h1b = (bfhi(R.hh[j][i]) - R.mr.x) * R.mr.y * g1v[2 * i + 1] + b1v[2 * i + 1];
            v[j][2 * i] = DN_ALPHA * h1a + w0 * fa.x + w1 * fb.x;
            v[j][2 * i + 1] = DN_ALPHA * h1b + w0 * fa.y + w1 * fb.y;
            sum += v[j][2 * i] + v[j][2 * i + 1]; }
    }
    const float mean = wave_sum(sum) * (1.0f / DM); float sq = 0.f;
#pragma unroll
    for (int j = 0; j < 4; ++j)
#pragma unroll
        for (int i = 0; i < 8; ++i) { v[j][i] -= mean; sq += v[j][i] * v[j][i]; }
    const float rstd = 1.0f / __builtin_sqrtf(wave_sum(sq) * (1.0f / DM) + LN_EPS);
#pragma unroll
    for (int j = 0; j < 4; ++j) {
        const int c = 512 * j + 8 * lane;
#pragma unroll
        for (int hq = 0; hq < 2; ++hq) { const int pq = ((2 * j + hq) * 64 + lane) * 4; const f32x4 gg = *(LAS const f32x4*)(gl + 4096 + pq), bb = *(LAS const f32x4*)(gl + 6144 + pq);
            f32x4 o; o.x = v[j][4 * hq] * rstd * gg.x + bb.x; o.y = v[j][4 * hq + 1] * rstd * gg.y + bb.y; o.z = v[j][4 * hq + 2] * rstd * gg.z + bb.z; o.w = v[j][4 * hq + 3] * rstd * gg.w + bb.w;
            *(f32x4*)(out + (size_t)row * DM + c + 4 * hq) = o; }
    }
}
__device__ __forceinline__ void final_ln(Frame& F) {
    moe_tables(F);
    LAS const int* ts = (LAS const int*)(F.lds + TAB_OFF);
    static_assert(MOE_F8, "the final phase rebuilds h1 from the pre-LN1 rows (fp8 MoE build)");
    const bf16* H1B = WSP(bf16, WS_Y); const f32x2* MR = WSP(f32x2, WS_MR); const unsigned char* YM = WSP(unsigned char, WS_YMOE); const unsigned* RT = WSP(unsigned, WS_RT);
    LAS float* gl = (LAS float*)(F.lds + RING_OFF);
    for (int i = F.tid; i < 2048; i += NWAVES * 64) { const int d = (((i >> 9) * 2 + ((i >> 2) & 1)) * 64 + ((i >> 3) & 63)) * 4 + (i & 3);
        gl[d] = F.in[14][i]; gl[2048 + d] = F.in[15][i]; gl[4096 + d] = F.in[23][i]; gl[6144 + d] = F.in[24][i]; }
    LDS_WAIT(); __syncthreads();
    const int step = F.G * NWAVES; int row = F.vcu * NWAVES + F.wave;
    if (row >= T) return;
    FinRow RA, RB;
    v4u rec = *(const v4u*)(RT + (size_t)row * 8); v2u wr2 = *(const v2u*)(RT + (size_t)row * 8 + 4);
    fin_issue(RA, H1B, MR, YM, ts, row, rec, wr2, F.lane);
    { const int rn = row + step < T ? row + step : row; rec = *(const v4u*)(RT + (size_t)rn * 8); wr2 = *(const v2u*)(RT + (size_t)rn * 8 + 4); }
    for (;;) {
        const int r1 = row + step; const bool h1 = r1 < T;
        if (h1) fin_issue(RB, H1B, MR, YM, ts, r1, rec, wr2, F.lane);
        { const int rn = r1 + step < T ? r1 + step : row; rec = *(const v4u*)(RT + (size_t)rn * 8); wr2 = *(const v2u*)(RT + (size_t)rn * 8 + 4); }
        fin_reduce(RA, F.out, gl, row, F.lane);
        if (!h1) break;
        const int r2 = r1 + step; const bool h2 = r2 < T;
        if (h2) fin_issue(RA, H1B, MR, YM, ts, r2, rec, wr2, F.lane);
        { const int rn = r2 + step < T ? r2 + step : row; rec = *(const v4u*)(RT + (size_t)rn * 8); wr2 = *(const v2u*)(RT + (size_t)rn * 8 + 4); }
        fin_reduce(RB, F.out, gl, r1, F.lane);
        if (!h2) break;
        row = r2;
    }
}
#ifndef MK_SPLIT
#define MK_SPLIT 0
#endif
constexpr int N_PHASES = 10;
#ifndef MOE_ALIGN
#define MOE_ALIGN true
#endif
#ifndef GEMM_ALIGN
#define GEMM_ALIGN true
#endif
#ifndef ATT_PROBE_MODE
#define ATT_PROBE_MODE 0
#endif
#ifndef SB_MASK
#define SB_MASK CVT_MASK
#endif
#ifndef P7_PROBE
#define P7_PROBE 0
#endif
#ifndef GEMM_PROBE_Q
#define GEMM_PROBE_Q 0
#endif
#ifndef REP_PHASE
#define REP_PHASE -1
#endif
__device__ __forceinline__ void fresh_ids(Frame& F) { int l = (int)__builtin_amdgcn_mbcnt_hi(~0u, __builtin_amdgcn_mbcnt_lo(~0u, 0u)); asm volatile("" : "+v"(l)); F.lane = l; F.tid = F.wave * 64 + l; }
__device__ __forceinline__ void phase0(Frame& F) { p0_prologue(F); }
__device__ __forceinline__ void phase1(Frame& F) {
    pg8::DenseSched S; S.init(WSP(bf16, WS_XB), WSP(bf16, WS_WIN), T, PITCH, DM, F.G, (int)blockIdx.x);
    EpiProj E{WSP(bf16, WS_PROJ), WSP(float, WS_NRM), (LAS float*)(F.lds + 135168)};
    static_assert(GEMM_ALIGN, "EpiProj's norm exchange has a workgroup barrier");
    pg8::gemm_phase<EpiProj, pg8::DenseSched, GEMM_ALIGN>(F.lds + RING_OFF, DM, S, E);
}
__device__ __forceinline__ void phase2(Frame& F) {
#ifdef NRM_CHECK
    att::att_norms<true>(F);
#endif
    for (int u = F.vcu; u < NB * 128 * 2; u += F.G) ssd::ssd_a_unit(F, u >> 8, (u >> 1) & 127, u & 1);
}
__device__ __forceinline__ void phase3(Frame& F, int rep = 0) {
    if (rep == 0 && (F.vcu & SB_MASK) == 0) ssd::ssd_b_queue(F);
    if (rep == 0 && (F.vcu & CVT_MASK) == 0) {
#if MOE_DEFER
        moe_convert(F);
#endif
        ssd::ssd_c_queue(F);
    }
    float lam;
    { const float s1 = wave_sum(F.in[2][F.lane] * F.in[3][F.lane]), s2 = wave_sum(F.in[4][F.lane] * F.in[5][F.lane]); lam = __expf(s1) - __expf(s2) + 0.2f; }
    volatile LAS unsigned* qslot = F.MISC + 16;
    const int myx = (int)(xb_xcc_id() & 7u);
    int sx = 0;
    __syncthreads();
    if (F.tid == 0) *qslot = __hip_atomic_fetch_add(F.ctl + CW_ATTQ + 64 * myx + 1024 * rep, 1u, RLX_AGENT);
    for (;;) {
        __syncthreads();
        const unsigned u = (unsigned)__builtin_amdgcn_readfirstlane((int)*qslot);
        const int x = (myx + sx) & 7;
        if (u >= 256u) {
            if (++sx == 8) break;
            __syncthreads();
            if (F.tid == 0) *qslot = __hip_atomic_fetch_add(F.ctl + CW_ATTQ + 64 * ((myx + sx) & 7) + 1024 * rep, 1u, RLX_AGENT);
            continue;
        }
        unsigned nxt = 0u;
        if (F.tid == 0) nxt = __hip_atomic_fetch_add(F.ctl + CW_ATTQ + 64 * x + 1024 * rep, 1u, RLX_AGENT);
        int hb[4]; { const int h0 = x, h1 = 7 - x, h2 = (x + 4) & 7, h3 = 7 - ((x + 4) & 7);
            hb[0] = h0 * 4 + 0; hb[1] = h1 * 4 + 1; hb[2] = h2 * 4 + 2; hb[3] = h3 * 4 + 3;
#pragma unroll
            for (int a = 0; a < 3; ++a)
#pragma unroll
                for (int c = 0; c < 3 - a; ++c) if (hb[c] < hb[c + 1]) { const int t_ = hb[c]; hb[c] = hb[c + 1]; hb[c + 1] = t_; } }
        const int pi = (int)(u >> 6), qb = 63 - (int)(u & 63u);
        const int key = __builtin_amdgcn_readfirstlane((pi == 0) ? hb[0] : (pi == 1) ? hb[1] : (pi == 2) ? hb[2] : hb[3]);
        if (rep == 0) att::attn_unit<0>(F, key & 3, key >> 2, qb, lam);
        else if (ATT_PROBE_MODE == 20) { if ((F.vcu & 3) == 0 && (u & 3u) == 0u) att::attn_unit<0>(F, key & 3, key >> 2, qb, lam); else __syncthreads(); }
        else att::attn_unit<(ATT_PROBE_MODE == 20 ? 0 : ATT_PROBE_MODE)>(F, key & 3, key >> 2, qb, lam);
        if (F.tid == 0) *qslot = nxt;
    }
    if (rep == 0) { ssd::ssd_b_queue(F);
#if MOE_DEFER
        moe_convert(F);
#endif
        ssd::ssd_c_queue(F);
    }
}
__device__ __forceinline__ void phase4(Frame& F) { (void)F; }
__device__ __forceinline__ void phase5(Frame& F) {
    pg8::DenseSched S; S.init(WSP(bf16, WS_XB), WSP(bf16, WS_WOUT), T, DM, DM, F.G, (int)blockIdx.x);
    EpiRes E{F.in[0], WSP(bf16, WS_Y), WSP(f32x2, WS_STAT)};
    pg8::gemm_phase<EpiRes, pg8::DenseSched, GEMM_ALIGN>(F.lds + RING_OFF, DM, S, E);
}
__device__ __forceinline__ void phase6(Frame& F) { ln1_router(F); }
__device__ __forceinline__ void phase7(Frame& F, int probe = 0) {
    moe_tables(F);
#if MOE_F8
    GateUpSched S{(const char*)WSP(unsigned char, WS_H1F8), (const char*)WSP(unsigned char, WS_WGU), WSP(int, WS_LIST), (LAS const int*)(F.lds + TAB_OFF), F.G, F.vcu, 2048u, 19};
    EpiGU8 E{probe == 3 ? (unsigned char*)nullptr : probe ? WSP(unsigned char, WS_XB) : WSP(unsigned char, WS_HID)};
    pg8::gemm_phase<EpiGU8, GateUpSched, MOE_ALIGN, true, 121>(F.lds + RING_OFF, probe == 2 ? DM / 4 : DM / 2, S, E);
#else
    GateUpSched S{(const char*)WSP(bf16, WS_H1B), (const char*)WSP(bf16, WS_WGU), WSP(int, WS_LIST), (LAS const int*)(F.lds + TAB_OFF), F.G, F.vcu, 4096u, 20};
    EpiGU E{WSP(bf16, WS_HID)};
    pg8::gemm_phase<EpiGU, GateUpSched, true>(F.lds + RING_OFF, DM, S, E);
#endif
}
__device__ __forceinline__ void phase8(Frame& F) {
    moe_tables(F);
#if MOE_F8
    DownSched S{(const char*)WSP(unsigned char, WS_HID), (const char*)WSP(unsigned char, WS_WDN), (LAS const int*)(F.lds + TAB_OFF), F.G, F.vcu, 1024u, 18};
    EpiDown E{WSP(bf16, WS_YMOE)};
    pg8::gemm_phase<EpiDown, DownSched, MOE_ALIGN, true, 121>(F.lds + RING_OFF, EHID / 2, S, E);
#else
    DownSched S{(const char*)WSP(bf16, WS_HID), (const char*)WSP(bf16, WS_WDN), (LAS const int*)(F.lds + TAB_OFF), F.G, F.vcu, 2048u, 19};
    EpiDown E{WSP(bf16, WS_YMOE)};
    pg8::gemm_phase<EpiDown, DownSched, true>(F.lds + RING_OFF, EHID, S, E);
#endif
}
__device__ __forceinline__ void phase9(Frame& F) { final_ln(F); }
struct Args { const float* in[25]; float* out; unsigned char* ws; int ph_lo, ph_hi, li, pad; };
__global__ void __launch_bounds__(NWAVES * 64, 2) fwd_kernel(Args args) {
    extern __shared__ __attribute__((aligned(16))) unsigned char lds_raw[];
    Frame F;
    F.lds = (LAS unsigned char*)lds_raw;
    F.MISC = (volatile LAS unsigned*)(F.lds + MISC_OFF);
    F.tid = threadIdx.x; F.lane = F.tid & 63; F.wave = __builtin_amdgcn_readfirstlane(F.tid >> 6);
    F.G = gridDim.x; { const int bx = blockIdx.x; F.vcu = (F.G % 8 == 0) ? (bx % 8) * (F.G / 8) + bx / 8 : bx; }
    F.ws = args.ws; F.out = args.out; F.ctl = (gu32*)(args.ws + WS_CTL);
#pragma unroll
    for (int i = 0; i < 25; ++i) F.in[i] = args.in[i];
    for (int u = F.tid; u < (LDS_BYTES - LDSCTL_OFF) / 4; u += NWAVES * 64) ((LAS unsigned*)(F.lds + LDSCTL_OFF))[u] = 0u;
    __syncthreads();
    XcdBarrier bar = xcd_barrier_post((unsigned*)(F.ctl + CW_BAR) + args.li * XCD_BAR_WORDS, F.MISC + 8);
    const int lo = args.ph_lo, hi = args.ph_hi;
#ifdef ONLY_PHASE
#define IN(k) ((k) == ONLY_PHASE && lo <= (k) && (k) < hi)
#else
#define IN(k) (lo <= (k) && (k) < hi)
#endif
#define SEAM(k) do { if (IN(k) && IN((k) + 1)) xcd_barrier(bar); } while (0)

    if (IN(0)) { phase0(F); if (REP_PHASE == 0) { __syncthreads(); phase0(F); } }
    SEAM(0);
    if (IN(1)) { phase1(F); if (REP_PHASE == 1) { if (!GEMM_PROBE_Q || (F.vcu & 3) == 0) phase1(F); } }
    SEAM(1);
    if (IN(2)) { phase2(F); if (REP_PHASE == 2) phase2(F); }
    SEAM(2);
    if (IN(3)) { phase3(F); if (REP_PHASE == 3) phase3(F, 1); }
    SEAM(4);
    if (IN(5)) { phase5(F); if (REP_PHASE == 5) phase5(F); }
    SEAM(5);
    if (IN(6)) { if (REP_PHASE == 6) ln1_router(F, CW_CNT + 4096, WS_HID, WS_HID + 8 * MiB); phase6(F); }
    SEAM(6);
    if (IN(7)) { phase7(F); if (REP_PHASE == 7) { if (!GEMM_PROBE_Q || (F.vcu & 3) == 0) phase7(F, P7_PROBE); } }
    SEAM(7);
    if (IN(8)) { phase8(F); if (REP_PHASE == 8) { if (!GEMM_PROBE_Q || (F.vcu & 3) == 0) phase8(F); } }
    SEAM(8);
    if (IN(9)) { phase9(F); if (REP_PHASE == 9) phase9(F); }
#ifdef NRM_CHECK
    __syncthreads();
    if (__hip_atomic_load(F.ctl + CW_CODE, RLX_AGENT) != 0u) { for (int i = F.tid; i < 4096; i += NWAVES * 64) F.out[(size_t)F.vcu * 4096 + i] = 1000.0f; }
#endif
#undef IN
#undef SEAM
}

extern "C" void kernel_launch(void* const* d_in, const int* in_sizes, int n_in, void* d_out, int out_size, void* d_ws, size_t ws_size, hipStream_t stream) {
    static int grid = 0;
    if (grid == 0) {
        if (n_in != 25 || out_size != T * DM || ws_size < WS_END) { fprintf(stderr, "kernel_launch: unexpected problem shape (n_in %d out %d ws %zu)\n", n_in, out_size, ws_size); grid = -1; return; }
        int dev = 0, cus = 0, per_cu = 0;
        if (hipGetDevice(&dev) != hipSuccess || hipDeviceGetAttribute(&cus, hipDeviceAttributeMultiprocessorCount, dev) != hipSuccess) { grid = -1; return; }
        if (hipFuncSetAttribute((const void*)fwd_kernel, hipFuncAttributeMaxDynamicSharedMemorySize, LDS_BYTES) != hipSuccess) { fprintf(stderr, "kernel_launch: hipFuncSetAttribute failed\n"); grid = -1; return; }
        if (hipOccupancyMaxActiveBlocksPerMultiprocessor(&per_cu, (const void*)fwd_kernel, NWAVES * 64, LDS_BYTES) != hipSuccess || per_cu < 1) fprintf(stderr, "kernel_launch: occupancy query reports %d\n", per_cu);
        (void)hipGetLastError();
        grid = cus;
    }
    if (grid < 0) return;
    if (hipMemsetAsync((char*)d_ws + WS_CTL, 0, CTL_ZERO_BYTES, stream) != hipSuccess) return;
    Args a{};
    for (int i = 0; i < 25; ++i) a.in[i] = (const float*)d_in[i];
    a.out = (float*)d_out; a.ws = (unsigned char*)d_ws; a.pad = 0;
#if MK_SPLIT
    for (int li = 0; li < N_PHASES; ++li) { a.ph_lo = li; a.ph_hi = li + 1; a.li = li; hipLaunchKernelGGL(fwd_kernel, dim3(grid), dim3(NWAVES * 64), LDS_BYTES, stream, a); }
#else
    a.ph_lo = 0; a.ph_hi = N_PHASES; a.li = 0;
    hipLaunchKernelGGL(fwd_kernel, dim3(grid), dim3(NWAVES * 64), LDS_BYTES, stream, a);
#endif
}
```

```cpp
#include <hip/hip_runtime.h>
#include <cstdio>
#include <cstdint>
#include <cstddef>
#ifndef F8_UNSCALED
#define F8_UNSCALED 1
#endif
namespace pg8 {
#define PG8_LAS __attribute__((address_space(3)))
typedef unsigned short bf16_t;
typedef short bf16x8 __attribute__((ext_vector_type(8)));
typedef float f32x4 __attribute__((ext_vector_type(4)));
typedef unsigned u32x4 __attribute__((ext_vector_type(4)));
typedef int i32x8 __attribute__((ext_vector_type(8)));
typedef int i32x4 __attribute__((ext_vector_type(4)));
constexpr int BM = 256, BK = 64, HALF = 128, HTB = HALF * BK * 2, STAGE_BYTES = 8 * HTB, NXCD = 8, WGM = 8;

__host__ __device__ __forceinline__ int lds_byte(int r, int c) { const int st = (r >> 4) * 2 + (c >> 5), rr = r & 15, cc = c & 31, ob = rr * 64 + cc * 2; return st * 1024 + (ob ^ (((ob >> 9) & 1) << 5)); }
__host__ __device__ __forceinline__ void stage_rc(int b, int& R, int& C) { const int st = b / 1024, sb = b % 1024, swz = sb ^ (((sb >> 9) & 1) << 5); R = (st >> 1) * 16 + swz / 64; C = (st & 1) * 32 + (swz % 64) / 2; }
__host__ __device__ __forceinline__ int perm32(int rho) { const int n = rho >> 4, i = rho & 15; return 8 * (i >> 2) + 4 * n + (i & 3); }

struct UnitP { const char* A; const char* B; unsigned ao[2][2]; int row0; int col0; int aux; int vr; };

__device__ __forceinline__ unsigned cvt_pk_bf16(float lo, float hi) { unsigned r; asm volatile("v_cvt_pk_bf16_f32 %0, %1, %2" : "=v"(r) : "v"(lo), "v"(hi)); return r; }

struct DenseSched {
    static constexpr bool RAGGED = false;
    const char* A; const char* Bt; int K; int nM, nN, nwg, G, c;
    __device__ __forceinline__ void init(const void* A_, const void* Bt_, int M, int N, int K_, int G_, int c_) { A = (const char*)A_; Bt = (const char*)Bt_; K = K_; nM = M / BM; nN = N / BM; nwg = nM * nN; G = G_; c = c_; }
    __device__ __forceinline__ bool get(int i, UnitP& u, const int (&R)[2], const int (&C)[2]) const {
        const long L = (long)i * G + c; if (L >= nwg) return false;
        int wgid = (int)L; { const int q = nwg / NXCD, r = nwg % NXCD, xcd = wgid % NXCD, off = wgid / NXCD; wgid = (xcd < r ? xcd * (q + 1) : r * (q + 1) + (xcd - r) * q) + off; }
        const int nig = WGM * nN, gid = wgid / nig, fm = gid * WGM, gsz = (nM - fm) < WGM ? (nM - fm) : WGM;
        const int pm = fm + ((wgid % nig) % gsz), pn = (wgid % nig) / gsz;
        const size_t tstep = (size_t)BM * K * 2;
        u.A = A + (size_t)pm * tstep; u.B = Bt + (size_t)pn * tstep; u.row0 = pm * BM; u.col0 = pn * BM; u.aux = pn; u.vr = BM;
#pragma unroll
        for (int h = 0; h < 2; ++h)
#pragma unroll
            for (int i2 = 0; i2 < 2; ++i2) u.ao[h][i2] = (unsigned)((h * HALF + R[i2]) * K + C[i2]) * 2u;
        return true;
    }
};

template <class Epi, class Sched, bool ALIGN_EPI, bool F8 = false, int SCALE_W = 127>
__device__ __forceinline__ void gemm_phase(PG8_LAS unsigned char* lds, const int K, const Sched& S, const Epi& E) {
    const int tid = threadIdx.x, wid = __builtin_amdgcn_readfirstlane(tid >> 6), lane = tid & 63, wr = wid >> 2, wc = wid & 3, fr = lane & 15, fq = lane >> 4;
    const int nt = K / BK;
    int R[2], C[2]; unsigned voffB[2];
#pragma unroll
    for (int i = 0; i < 2; ++i) { stage_rc(tid * 16 + i * 8192, R[i], C[i]); const int Rb = Epi::PERM ? ((R[i] & ~31) + perm32(R[i] & 31)) : R[i]; voffB[i] = (unsigned)(Rb * K + C[i]) * 2u; }
    const size_t kstep = (size_t)(BK * 2);
    const size_t hstep = (size_t)HALF * K * 2;
    const unsigned ldsw = (unsigned)wid * 1024u;
    const unsigned lds0 = (unsigned)(uintptr_t)lds;
    const int aoff = lds_byte(wr * 64 + fr, fq * 8), boff = lds_byte(wc * 32 + fr, fq * 8);
#define PG8_SA(b, h) (((b) * 2 + (h)) * HTB)
#define PG8_SB(b, h) ((4 + (b) * 2 + (h)) * HTB)
#define PG8_GLDS(gbase, voff32, ldsaddr) do { unsigned keep_; asm volatile("s_mov_b32 %0, m0\n\ts_mov_b32 m0, %3\n\ts_nop 0\n\tglobal_load_lds_dwordx4 %1, %2\n\ts_mov_b32 m0, %0" \
        : "=&s"(keep_) : "v"(voff32), "s"(gbase), "s"(ldsaddr) : "memory"); } while (0)
#define PG8_STAGE_B(bufoff, gbase) do { _Pragma("unroll") for (int _i = 0; _i < 2; ++_i) PG8_GLDS((const char*)(gbase), voffB[_i], lds0 + (unsigned)(bufoff) + ldsw + (unsigned)(_i * 8192)); } while (0)
#define PG8_STAGE_A(bufoff, gbase, offs) do { _Pragma("unroll") for (int _i = 0; _i < 2; ++_i) PG8_GLDS((const char*)(gbase), (offs)[_i], lds0 + (unsigned)(bufoff) + ldsw + (unsigned)(_i * 8192)); } while (0)
#define PG8_LDA(dst, b, h) do { _Pragma("unroll") for (int m = 0; m < 4; ++m) { \
        { const i32x4 lo_ = *(const PG8_LAS i32x4*)(lds + PG8_SA(b, h) + aoff + m * 2048), hi_ = *(const PG8_LAS i32x4*)(lds + PG8_SA(b, h) + aoff + m * 2048 + 1024); dst[m] = __builtin_shufflevector(lo_, hi_, 0, 1, 2, 3, 4, 5, 6, 7); } } } while (0)
#define PG8_LDB(dst, b, h) do { _Pragma("unroll") for (int n = 0; n < 2; ++n) { \
        { const i32x4 lo_ = *(const PG8_LAS i32x4*)(lds + PG8_SB(b, h) + boff + n * 2048), hi_ = *(const PG8_LAS i32x4*)(lds + PG8_SB(b, h) + boff + n * 2048 + 1024); dst[n] = __builtin_shufflevector(lo_, hi_, 0, 1, 2, 3, 4, 5, 6, 7); } } } while (0)
#define PG8_MMA(ai, bj, At, Bt) do { __builtin_amdgcn_s_setprio(1); _Pragma("unroll") for (int m = 0; m < 4; ++m) _Pragma("unroll") for (int n = 0; n < 2; ++n) { \
        if constexpr (F8) { if (F8_UNSCALED) asm volatile("v_mfma_f32_16x16x128_f8f6f4 %0, %1, %2, %0" : "+v"(acc[ai][bj][m][n]) : "v"(Bt[n]), "v"(At[m])); \
            else asm volatile("v_mfma_scale_f32_16x16x128_f8f6f4 %0, %1, %2, %0, %3, %4 op_sel_hi:[0,0,0]" : "+v"(acc[ai][bj][m][n]) : "v"(Bt[n]), "v"(At[m]), "v"(sc_w), "v"(sc_a)); } \
        else { const i32x8 b_ = Bt[n], a_ = At[m]; \
            acc[ai][bj][m][n] = __builtin_amdgcn_mfma_f32_16x16x32_bf16(__builtin_bit_cast(bf16x8, __builtin_shufflevector(b_, b_, 0, 1, 2, 3)), __builtin_bit_cast(bf16x8, __builtin_shufflevector(a_, a_, 0, 1, 2, 3)), acc[ai][bj][m][n], 0, 0, 0); \
            acc[ai][bj][m][n] = __builtin_amdgcn_mfma_f32_16x16x32_bf16(__builtin_bit_cast(bf16x8, __builtin_shufflevector(b_, b_, 4, 5, 6, 7)), __builtin_bit_cast(bf16x8, __builtin_shufflevector(a_, a_, 4, 5, 6, 7)), acc[ai][bj][m][n], 0, 0, 0); } } \
        __builtin_amdgcn_s_setprio(0); } while (0)
#define PG8_WAIT_V(n) asm volatile("s_waitcnt vmcnt(" #n ")" ::: "memory")
#define PG8_WAIT_L(n) asm volatile("s_waitcnt lgkmcnt(" #n ")" ::: "memory")
#define PG8_BAR __builtin_amdgcn_s_barrier()
#define PG8_SCHED __builtin_amdgcn_sched_barrier(0)
    UnitP cur, nxt; int ui = 0;
    if (!S.get(0, cur, R, C)) return;
    f32x4 acc[2][2][4][2];
#pragma unroll
    for (int a = 0; a < 2; ++a)
#pragma unroll
        for (int b = 0; b < 2; ++b)
#pragma unroll
            for (int m = 0; m < 4; ++m)
#pragma unroll
                for (int n = 0; n < 2; ++n) acc[a][b][m][n] = (f32x4){0.f, 0.f, 0.f, 0.f};
    int sc_w = SCALE_W, sc_a = 127; if constexpr (F8) asm volatile("" : "+v"(sc_w), "+v"(sc_a));
    i32x8 At[4], B0[2], B1[2];
    {
        const char* cA = cur.A; const char* cB = cur.B;
        PG8_STAGE_B(PG8_SB(0, 0), cB); PG8_STAGE_B(PG8_SB(0, 1), cB + hstep); PG8_STAGE_A(PG8_SA(0, 0), cA, cur.ao[0]); PG8_STAGE_A(PG8_SA(0, 1), cA, cur.ao[1]);
        if (wr == 1) PG8_BAR;
        PG8_WAIT_V(2); PG8_BAR;
        PG8_STAGE_B(PG8_SB(1, 0), cB + kstep); PG8_STAGE_A(PG8_SA(1, 0), cA + kstep, cur.ao[0]); PG8_STAGE_B(PG8_SB(1, 1), cB + hstep + kstep);
        PG8_WAIT_V(6); PG8_BAR;
    }
    for (;;) {
        const bool has_next = S.get(ui + 1, nxt, R, C);
        if (!has_next) nxt = cur;
        const char* cA = cur.A; const char* cB = cur.B; const char* nA = nxt.A; const char* nB = nxt.B;
        const bool va0 = !Sched::RAGGED || cur.vr > wr * 64, va1 = !Sched::RAGGED || cur.vr > 128 + wr * 64;
#pragma nounroll
        for (int t = 0; t < nt; t += 2) {
            const bool last = (t == nt - 2);
            const char* a1 = cA + (size_t)(t + 1) * kstep;
            const char* a2 = last ? nA : cA + (size_t)(t + 2) * kstep; const char* b2 = last ? nB : cB + (size_t)(t + 2) * kstep;
            const char* a3 = a2 + kstep; const char* b3 = b2 + kstep;
            unsigned o2[2][2];
#pragma unroll
            for (int h = 0; h < 2; ++h)
#pragma unroll
                for (int i = 0; i < 2; ++i) o2[h][i] = last ? nxt.ao[h][i] : cur.ao[h][i];
            if (va0) { PG8_LDB(B0, 0, 0); PG8_LDB(B1, 0, 1); } PG8_SCHED; if (va0) PG8_LDA(At, 0, 0); PG8_STAGE_A(PG8_SA(1, 1), a1, cur.ao[1]);
            PG8_WAIT_V(8); PG8_WAIT_L(0); PG8_BAR; if (va0) { PG8_MMA(0, 0, At, B0); PG8_MMA(0, 1, At, B1); } PG8_BAR; PG8_SCHED;
            if (va1) PG8_LDA(At, 0, 1); PG8_STAGE_B(PG8_SB(0, 0), b2); PG8_STAGE_B(PG8_SB(0, 1), b2 + hstep); PG8_STAGE_A(PG8_SA(0, 0), a2, o2[0]);
            PG8_WAIT_V(8); PG8_WAIT_L(0); PG8_BAR; if (va1) { PG8_MMA(1, 0, At, B0); PG8_MMA(1, 1, At, B1); } PG8_BAR; PG8_SCHED;
            if (va0) { PG8_LDB(B0, 1, 0); PG8_LDB(B1, 1, 1); } PG8_SCHED; if (va0) PG8_LDA(At, 1, 0); PG8_STAGE_A(PG8_SA(0, 1), a2, o2[1]);
            PG8_WAIT_V(8); PG8_WAIT_L(0); PG8_BAR; if (va0) { PG8_MMA(0, 0, At, B0); PG8_MMA(0, 1, At, B1); } PG8_BAR; PG8_SCHED;
            if (va1) PG8_LDA(At, 1, 1); PG8_STAGE_B(PG8_SB(1, 0), b3); PG8_STAGE_B(PG8_SB(1, 1), b3 + hstep); PG8_STAGE_A(PG8_SA(1, 0), a3, o2[0]);
            PG8_WAIT_V(8); PG8_WAIT_L(0); PG8_BAR; if (va1) { PG8_MMA(1, 0, At, B0); PG8_MMA(1, 1, At, B1); } PG8_BAR; PG8_SCHED;
        }
        if constexpr (ALIGN_EPI) { if (wr == 0) PG8_BAR; }
        if constexpr (F8) asm volatile("s_nop 15\n\ts_nop 15" ::: "memory");
        E(acc, cur, wr, wc, fr, fq);
        if (!has_next) break;
#pragma unroll
        for (int a = 0; a < 2; ++a)
#pragma unroll
            for (int b = 0; b < 2; ++b)
#pragma unroll
                for (int m = 0; m < 4; ++m)
#pragma unroll
                    for (int n = 0; n < 2; ++n) acc[a][b][m][n] = (f32x4){0.f, 0.f, 0.f, 0.f};
        cur = nxt; ++ui;
        if constexpr (ALIGN_EPI) { if (wr == 1) PG8_BAR; }
    }
    PG8_WAIT_V(0);
    if constexpr (!ALIGN_EPI) { if (wr == 0) PG8_BAR; }
    PG8_BAR;
#undef PG8_SA
#undef PG8_SB
#undef PG8_STAGE_A
#undef PG8_GLDS
#undef PG8_STAGE_B
#undef PG8_LDA
#undef PG8_LDB
#undef PG8_MMA
#undef PG8_WAIT_V
#undef PG8_WAIT_L
#undef PG8_BAR
#undef PG8_SCHED
}
}
constexpr int NWAVES = 8;
constexpr int NB = 4, SEQ = 8192, T = NB * SEQ, DM = 2048;
constexpr int PITCH = 5632;
constexpr int QC = 0, KC = 1024, VC = 2048, ZC = 3072, XC = 4096;
constexpr int IN_COLS = 5648;
constexpr int NEXP = 32, EHID = 1024;
constexpr int CAP_ROWS = (2 * T / 256 + NEXP) * 256;
constexpr float DN_ALPHA = 1.189207115002721f;
constexpr float LN_EPS = 1e-5f, RMS_EPS = 1e-6f;
constexpr float LOG2E = 1.4426950408889634f;
constexpr float QSCALE = 0.125f * LOG2E;

constexpr size_t MiB = 1u << 20;
constexpr size_t WS_CTL = 0, CTL_ZERO_BYTES = 1 * MiB;
constexpr size_t WS_DT = 2 * MiB;
constexpr size_t WS_RT = 4 * MiB;
constexpr size_t WS_LIST = 5 * MiB;
constexpr size_t WS_STAT = 9 * MiB;
constexpr size_t WS_CD = 17 * MiB;
constexpr size_t WS_NRM = 17 * MiB + 512 * 1024;
constexpr size_t WS_WRT = 18 * MiB;
constexpr size_t WS_WIN = 20 * MiB;
constexpr size_t WS_WOUT = 42 * MiB;
constexpr size_t WS_WDN = 50 * MiB;
constexpr size_t WS_WGU = 178 * MiB;
constexpr size_t WS_CONV = 306 * MiB;
constexpr size_t WS_XB = 434 * MiB;
constexpr size_t WS_PROJ = 562 * MiB;
constexpr size_t WS_H1B = WS_PROJ;
constexpr size_t WS_Y = WS_PROJ;
constexpr size_t WS_MR = WS_NRM;
constexpr size_t WS_HID = WS_PROJ + 128 * MiB;
constexpr size_t WS_YMOE = WS_WGU;
constexpr size_t WS_H1F8 = WS_PROJ + 200 * MiB;
constexpr size_t WS_END = 914 * MiB;
static_assert(WS_CONV + (size_t)T * 1280 * 2 <= WS_XB, "conv cache fits below xb");
static_assert(WS_HID + (size_t)CAP_ROWS * EHID * 2 <= WS_END, "hid fits in proj region");
static_assert(WS_YMOE + (size_t)CAP_ROWS * DM * 2 <= WS_PROJ, "ymoe fits below proj");
constexpr int CW_TMO = 0, CW_CODE = 1;
constexpr int CW_CNT = 8192;
constexpr int CW_SBQ = 2048, CW_SBDONE = 2112, CW_SCQ = 2176;
constexpr int CW_CVQ = 192;
constexpr int CW_ATTQ = 256;
constexpr int CW_BAR = 4096;

constexpr int RING_OFF = 0, RING_BYTES = 131072;
constexpr int LDSCTL_OFF = RING_BYTES, MISC_OFF = LDSCTL_OFF + 320;
constexpr int TAB_OFF = LDSCTL_OFF + 1024;
constexpr int LDS_BYTES = 147456;

#ifndef MOE_F8
#define MOE_F8 1
#endif
#ifndef MOE_DEFER
#define MOE_DEFER (MOE_F8 ? 1 : 0)
#endif
#ifndef CVT_MASK
#define CVT_MASK 3
#endif
#define GAS __attribute__((address_space(1)))
#define LAS __attribute__((address_space(3)))
typedef unsigned short bf16;
typedef unsigned v4u __attribute__((ext_vector_type(4)));
typedef unsigned v2u __attribute__((ext_vector_type(2)));
typedef float f32x4 __attribute__((ext_vector_type(4)));
typedef float f32x2 __attribute__((ext_vector_type(2)));
typedef float f32x16 __attribute__((ext_vector_type(16)));
typedef short bf16x8 __attribute__((ext_vector_type(8)));
typedef short s16x4 __attribute__((ext_vector_type(4)));
typedef GAS unsigned gu32;
#define RLX_AGENT __ATOMIC_RELAXED, __HIP_MEMORY_SCOPE_AGENT
#define LDS_WAIT() asm volatile("s_waitcnt lgkmcnt(0)" ::: "memory")
#define VM_WAIT() asm volatile("s_waitcnt vmcnt(0)" ::: "memory")
__device__ __forceinline__ unsigned f2bf(float f) { unsigned u = __builtin_bit_cast(unsigned, f); return (u + 0x7fffu + ((u >> 16) & 1u)) >> 16; }
__device__ __forceinline__ unsigned pk2(float lo, float hi) { return f2bf(lo) | (f2bf(hi) << 16); }
__device__ __forceinline__ unsigned pk4_fp8(float a, float b, float c, float d) { int r = __builtin_amdgcn_cvt_pk_fp8_f32(a, b, 0, false); r = __builtin_amdgcn_cvt_pk_fp8_f32(c, d, r, true); return (unsigned)r; }
__device__ __forceinline__ float bflo(unsigned u) { return __builtin_bit_cast(float, u << 16); }
__device__ __forceinline__ float bfhi(unsigned u) { return __builtin_bit_cast(float, u & 0xffff0000u); }
__device__ __forceinline__ float wave_sum(float v) {
#pragma unroll
    for (int o = 1; o < 64; o <<= 1) v += __shfl_xor(v, o);
    return v;
}

#define XB_TMO      128
#define XB_XCNT(j)  (256  + 64 * (j))
#define XB_XSUB(j)  (1280 + 64 * (j))
#define XB_XGEN(j)  (2304 + 64 * (j))
#define XB_TOP      3328
#define XB_TOPGEN   3392
#define XCD_BAR_WORDS 3456
#define XB_SPIN_CAP (1u << 18)

__device__ __forceinline__ unsigned xb_ld(unsigned* p)              { return __hip_atomic_load(p, __ATOMIC_RELAXED, __HIP_MEMORY_SCOPE_AGENT); }
__device__ __forceinline__ unsigned xb_add(unsigned* p, unsigned v) { return __hip_atomic_fetch_add(p, v, __ATOMIC_RELAXED, __HIP_MEMORY_SCOPE_AGENT); }
__device__ __forceinline__ unsigned xb_xcc_id() { return (unsigned)__builtin_amdgcn_s_getreg((3 << 11) | 20) & 0xFu; }
#define XB_SPIN(cond, bar) do { unsigned _sp = 0; while (cond) { __builtin_amdgcn_s_sleep(1); \
    if ((++_sp & 255u) == 0u) { if (xb_ld(&(bar)[XB_TMO])) break; if (_sp > XB_SPIN_CAP) { atomicAdd(&(bar)[XB_TMO], 1u); break; } } } } while (0)

struct XcdBarrier { unsigned* bar; unsigned x; volatile LAS unsigned* st; };

__device__ __forceinline__ XcdBarrier xcd_barrier_post(unsigned* bar, volatile LAS unsigned* st) {
    XcdBarrier b; b.bar = bar; b.x = xb_xcc_id(); b.st = st;
    if (threadIdx.x == 0) (void)xb_add(&bar[XB_XCNT(b.x)], 1u);
    return b;
}
__device__ __forceinline__ void xcd_barrier_complete(unsigned* bar, unsigned x, unsigned& nloc, unsigned& nx) {
    const unsigned G = gridDim.x * gridDim.y * gridDim.z;
    unsigned sum, cnt, mine, sp = 0u;
    for (;;) {
        sum = 0u; cnt = 0u; mine = 0u;
#pragma unroll
        for (unsigned j = 0; j < 16; ++j) { const unsigned c = xb_ld(&bar[XB_XCNT(j)]); sum += c; cnt += (c > 0u) ? 1u : 0u; mine = (j == x) ? c : mine; }
        if (sum == G) break;
        __builtin_amdgcn_s_sleep(1);
        if ((++sp & 255u) == 0u) { if (xb_ld(&bar[XB_TMO])) break; if (sp > XB_SPIN_CAP) { atomicAdd(&bar[XB_TMO], 1u); break; } }
    }
    nloc = mine > 0u ? mine : 1u; nx = cnt > 0u ? cnt : 1u;
}
__device__ __forceinline__ void xcd_barrier(const XcdBarrier& b) {
    asm volatile("s_waitcnt vmcnt(0)" ::: "memory");
    __syncthreads();
    if (threadIdx.x == 0) {
        unsigned* bar = b.bar;
        __builtin_amdgcn_s_waitcnt(0);
        unsigned nloc = b.st[0], nx = b.st[1];
        if (nloc == 0u) { xcd_barrier_complete(bar, b.x, nloc, nx); b.st[0] = nloc; b.st[1] = nx; }
        const unsigned old = xb_add(&bar[XB_XSUB(b.x)], 1u);
        const unsigned gen = old / nloc;
        if (old + 1u == (gen + 1u) * nloc) {
            __builtin_amdgcn_fence(__ATOMIC_RELEASE, "agent");
            asm volatile("s_waitcnt vmcnt(0)" ::: "memory");
            const unsigned og = xb_add(&bar[XB_TOP], 1u);
            const unsigned tg = og / nx;
            if (og + 1u == (tg + 1u) * nx) xb_add(&bar[XB_TOPGEN], 1u);
            else XB_SPIN(xb_ld(&bar[XB_TOPGEN]) == tg, bar);
            __builtin_amdgcn_fence(__ATOMIC_ACQUIRE, "agent");
            xb_add(&bar[XB_XGEN(b.x)], 1u);
            asm volatile("s_waitcnt vmcnt(0)" ::: "memory");
        } else {
            XB_SPIN(xb_ld(&bar[XB_XGEN(b.x)]) == gen, bar);
            __builtin_amdgcn_fence(__ATOMIC_ACQUIRE, "agent");
            asm volatile("s_waitcnt vmcnt(0)" ::: "memory");
        }
    }
    __syncthreads();
}

struct Frame {
    LAS unsigned char* lds;
    volatile LAS unsigned* MISC;
    gu32* ctl;
    int tid, lane, wave;
    int vcu, G;
    const float* in[25];
    float* out;
    unsigned char* ws;
};
#define WSP(T_, off) ((T_*)(F.ws + (off)))
typedef short v4i16_t __attribute__((ext_vector_type(4)));
__device__ __forceinline__ s16x4 lds_tr16(LAS const unsigned char* p) { return __builtin_bit_cast(s16x4, __builtin_amdgcn_ds_read_tr16_b64_v4i16((LAS v4i16_t*)p)); }

__device__ __forceinline__ void p0_tr_item(const float* __restrict__ W, size_t ld, bf16* __restrict__ WT, size_t Kd, LAS unsigned char* scr, int lane) {
    const int rs = lane >> 4, c = lane & 15;
    f32x4 v[16];
#pragma unroll
    for (int j = 0; j < 16; ++j) v[j] = *(const f32x4*)(W + (size_t)(4 * j + rs) * ld + 4 * c);
#pragma unroll
    for (int j = 0; j < 16; ++j) { v2u o; o.x = pk2(v[j].x, v[j].y); o.y = pk2(v[j].z, v[j].w); *(LAS v2u*)(scr + (4 * j + rs) * 160 + 8 * c) = o; }
    LDS_WAIT(); asm volatile("" ::: "memory");
    const int q = (lane & 15) >> 2, p = lane & 3, gg = lane >> 4, i = lane & 15;
#pragma unroll
    for (int s = 0; s < 8; ++s) {
        const int nb = s >> 1, kp = 8 * ((s & 1) * 4 + gg);
        const s16x4 lo = lds_tr16(scr + (kp + q) * 160 + (16 * nb + 4 * p) * 2);
        const s16x4 hi = lds_tr16(scr + (kp + 4 + q) * 160 + (16 * nb + 4 * p) * 2);
        const bf16x8 o = __builtin_shufflevector(lo, hi, 0, 1, 2, 3, 4, 5, 6, 7);
        *(bf16x8*)(WT + (size_t)(16 * nb + i) * Kd + kp) = o;
    }
    LDS_WAIT(); asm volatile("" ::: "memory");
}

__device__ __forceinline__ void p0_tr_item8(const float* __restrict__ W, size_t ld, unsigned char* __restrict__ WT8, size_t Kd, LAS unsigned char* scr, int lane, float scale) {
    const int rs = lane >> 4, c = lane & 15;
#pragma unroll
    for (int hb = 0; hb < 2; ++hb) {
        f32x4 va[8], vb[8];
#pragma unroll
        for (int j = 0; j < 8; ++j) { const int kp = 32 * hb + 4 * j + rs; va[j] = *(const f32x4*)(W + (size_t)(2 * kp) * ld + 4 * c); vb[j] = *(const f32x4*)(W + (size_t)(2 * kp + 1) * ld + 4 * c); }
#pragma unroll
        for (int j = 0; j < 8; ++j) { const int kp = 32 * hb + 4 * j + rs; const f32x4 a = va[j] * scale, b = vb[j] * scale;
            v2u o; o.x = pk4_fp8(a.x, b.x, a.y, b.y); o.y = pk4_fp8(a.z, b.z, a.w, b.w); *(LAS v2u*)(scr + kp * 160 + 8 * c) = o; }
    }
    LDS_WAIT(); asm volatile("" ::: "memory");
    const int q = (lane & 15) >> 2, p = lane & 3, gg = lane >> 4, i = lane & 15;
#pragma unroll
    for (int s = 0; s < 8; ++s) {
        const int nb = s >> 1, kp = 8 * ((s & 1) * 4 + gg);
        const s16x4 lo = lds_tr16(scr + (kp + q) * 160 + (16 * nb + 4 * p) * 2);
        const s16x4 hi = lds_tr16(scr + (kp + 4 + q) * 160 + (16 * nb + 4 * p) * 2);
        const bf16x8 o = __builtin_shufflevector(lo, hi, 0, 1, 2, 3, 4, 5, 6, 7);
        *(bf16x8*)(WT8 + (size_t)(16 * nb + i) * Kd + 2 * kp) = o;
    }
    LDS_WAIT(); asm volatile("" ::: "memory");
}

__device__ __forceinline__ void p0_prologue(Frame& F) {
    const float* x = F.in[0]; const float* w_in = F.in[1];
    {
        LAS float* wdt = (LAS float*)(F.lds + RING_OFF);
        for (int idx = F.tid; idx < 2048 * 16; idx += NWAVES * 64) { const int k = idx >> 4, col = idx & 15; wdt[col * 2052 + k] = w_in[(size_t)k * IN_COLS + 5632 + col]; }
        __syncthreads();
        bf16* XB = WSP(bf16, WS_XB); float* DT = WSP(float, WS_DT);
        const int r = F.lane & 15, kq = F.lane >> 4;
        for (int grp = F.vcu * NWAVES + F.wave; grp < T / 16; grp += F.G * NWAVES) {
            const float* xrow = x + (size_t)(grp * 16 + r) * DM + 8 * kq;
            bf16* xbrow = XB + (size_t)(grp * 16 + r) * DM + 8 * kq;
            LAS const float* wrow = wdt + r * 2052 + 8 * kq;
            f32x4 acc = (f32x4){0.f, 0.f, 0.f, 0.f};
            f32x4 xq[2][8][2];
#pragma unroll
            for (int j = 0; j < 8; ++j) { xq[0][j][0] = *(const f32x4*)(xrow + 32 * j); xq[0][j][1] = *(const f32x4*)(xrow + 32 * j + 4); }
#pragma nounroll
            for (int b2 = 0; b2 < 4; ++b2) {
#pragma unroll
                for (int hb = 0; hb < 2; ++hb) {
                    const int blk = 2 * b2 + hb;
                    if (blk < 7) {
#pragma unroll
                        for (int j = 0; j < 8; ++j) { xq[hb ^ 1][j][0] = *(const f32x4*)(xrow + 32 * (8 * (blk + 1) + j)); xq[hb ^ 1][j][1] = *(const f32x4*)(xrow + 32 * (8 * (blk + 1) + j) + 4); }
                    }
#pragma unroll
                    for (int j = 0; j < 8; ++j) {
                        const int s = 8 * blk + j;
                        const f32x4 a = xq[hb][j][0], a2 = xq[hb][j][1];
                        const f32x4 bw = *(LAS const f32x4*)(wrow + 32 * s), bw2 = *(LAS const f32x4*)(wrow + 32 * s + 4);
                        acc = __builtin_amdgcn_mfma_f32_16x16x4f32(a.x, bw.x, acc, 0, 0, 0);
                        acc = __builtin_amdgcn_mfma_f32_16x16x4f32(a.y, bw.y, acc, 0, 0, 0);
                        acc = __builtin_amdgcn_mfma_f32_16x16x4f32(a.z, bw.z, acc, 0, 0, 0);
                        acc = __builtin_amdgcn_mfma_f32_16x16x4f32(a.w, bw.w, acc, 0, 0, 0);
                        acc = __builtin_amdgcn_mfma_f32_16x16x4f32(a2.x, bw2.x, acc, 0, 0, 0);
                        acc = __builtin_amdgcn_mfma_f32_16x16x4f32(a2.y, bw2.y, acc, 0, 0, 0);
                        acc = __builtin_amdgcn_mfma_f32_16x16x4f32(a2.z, bw2.z, acc, 0, 0, 0);
                        acc = __builtin_amdgcn_mfma_f32_16x16x4f32(a2.w, bw2.w, acc, 0, 0, 0);
                        v4u o; o.x = pk2(a.x, a.y); o.y = pk2(a.z, a.w); o.z = pk2(a2.x, a2.y); o.w = pk2(a2.z, a2.w);
                        *(v4u*)(xbrow + 32 * s) = o;
                    }
                }
            }
#pragma unroll
            for (int rg = 0; rg < 4; ++rg) DT[(size_t)(grp * 16 + 4 * kq + rg) * 16 + r] = acc[rg];
        }
        __syncthreads();
    }
    {
        bf16* WRH = WSP(bf16, WS_WRT); bf16* WRL = WRH + 48 * 2048; const float* wrg = F.in[16]; const float* wre = F.in[18];
        for (int idx = F.vcu * NWAVES * 64 + F.tid; idx < 48 * 2048; idx += F.G * NWAVES * 64) {
            const int col = idx >> 11, k = idx & 2047; float v = 0.f;
            if (col < 4) v = wrg[k * 4 + col];
            else if (col < 36) { const int g = (col - 4) >> 3, e = (col - 4) & 7; v = wre[((size_t)g * 2048 + k) * 8 + e]; }
            const unsigned hi = f2bf(v); const float rem = v - bflo(hi);
            WRH[idx] = (bf16)hi; WRL[idx] = (bf16)f2bf(rem);
        }
    }
    {
        LAS unsigned char* scr = F.lds + RING_OFF + F.wave * 10240;
        const int gw = F.vcu * NWAVES + F.wave, NGW = F.G * NWAVES;
#if MOE_F8
        constexpr int I_IN = 32 * 88, I_OUT = 32 * 32, I_G = 16 * 16, I_D = 8 * 32;
#else
        constexpr int I_IN = 32 * 88, I_OUT = 32 * 32, I_G = 32 * 16, I_D = 16 * 32;
#endif
        constexpr int NITEMS = I_IN + I_OUT + (MOE_DEFER ? 0 : NEXP * (2 * I_G + I_D));
        bf16* WIN = WSP(bf16, WS_WIN); bf16* WOUT = WSP(bf16, WS_WOUT); bf16* WGU = WSP(bf16, WS_WGU); bf16* WDN = WSP(bf16, WS_WDN);
        for (int it = gw; it < NITEMS; it += NGW) {
            int r = it;
            if (r < I_IN) { const int kb = r / 88, nb = r % 88; p0_tr_item(w_in + (size_t)(64 * kb) * IN_COLS + 64 * nb, IN_COLS, WIN + (size_t)(64 * nb) * 2048 + 64 * kb, 2048, scr, F.lane); continue; }
            r -= I_IN;
            if (r < I_OUT) { const int kb = r / 32, nb = r % 32; p0_tr_item(F.in[13] + (size_t)(64 * kb) * 2048 + 64 * nb, 2048, WOUT + (size_t)(64 * nb) * 2048 + 64 * kb, 2048, scr, F.lane); continue; }
            r -= I_OUT;
            const int e = r / (2 * I_G + I_D); r -= e * (2 * I_G + I_D);
#if MOE_F8
            if (r < 2 * I_G) {
                const int up = r >= I_G; if (up) r -= I_G;
                const int kb = r / 16, nb = r % 16, n0 = 64 * nb;
                const float* src = (up ? F.in[21] : F.in[20]) + ((size_t)e * 2048 + 128 * kb) * 1024 + n0;
                const int drow = (n0 >> 7) * 256 + (n0 & 127) + (up ? 128 : 0);
                p0_tr_item8(src, 1024, (unsigned char*)WGU + ((size_t)e * 2048 + drow) * 2048 + 128 * kb, 2048, scr, F.lane, 64.f);
            } else {
                r -= 2 * I_G; const int kb = r / 32, nb = r % 32;
                p0_tr_item8(F.in[22] + ((size_t)e * 1024 + 128 * kb) * 2048 + 64 * nb, 2048, (unsigned char*)WDN + ((size_t)e * 2048 + 64 * nb) * 1024 + 128 * kb, 1024, scr, F.lane, 64.f);
            }
#else
            if (r < 2 * I_G) {
                const int up = r >= I_G; if (up) r -= I_G;
                const int kb = r / 16, nb = r % 16, n0 = 64 * nb;
                const float* src = (up ? F.in[21] : F.in[20]) + ((size_t)e * 2048 + 64 * kb) * 1024 + n0;
                const int drow = (n0 >> 7) * 256 + (n0 & 127) + (up ? 128 : 0);
                p0_tr_item(src, 1024, WGU + ((size_t)e * 2048 + drow) * 2048 + 64 * kb, 2048, scr, F.lane);
            } else {
                r -= 2 * I_G; const int kb = r / 32, nb = r % 32;
                p0_tr_item(F.in[22] + ((size_t)e * 1024 + 64 * kb) * 2048 + 64 * nb, 2048, WDN + ((size_t)e * 2048 + 64 * nb) * 1024 + 64 * kb, 1024, scr, F.lane);
            }
#endif
        }
    }
}

#if MOE_F8
__device__ __forceinline__ void moe_convert(Frame& F) {
    constexpr int I_G = 16 * 16, I_D = 8 * 32, PER_E = 2 * I_G + I_D, NCH = NEXP * PER_E / 8;
    LAS unsigned char* scr = F.lds + RING_OFF + F.wave * 10240;
    volatile LAS unsigned* qslot = F.MISC + 17;
    unsigned char* WGU = WSP(unsigned char, WS_WGU); unsigned char* WDN = WSP(unsigned char, WS_WDN);
    for (;;) {
        __syncthreads();
        if (F.tid == 0) *qslot = __hip_atomic_fetch_add(F.ctl + CW_CVQ, 1u, RLX_AGENT);
        __syncthreads();
        const unsigned ch = *qslot;
        if (ch >= (unsigned)NCH) break;
        int r = (int)ch * 8 + F.wave;
        const int e = r / PER_E; r -= e * PER_E;
        if (r < 2 * I_G) {
            const int up = r >= I_G; if (up) r -= I_G;
            const int kb = r / 16, nb = r % 16, n0 = 64 * nb;
            const float* src = (up ? F.in[21] : F.in[20]) + ((size_t)e * 2048 + 128 * kb) * 1024 + n0;
            const int drow = (n0 >> 7) * 256 + (n0 & 127) + (up ? 128 : 0);
            p0_tr_item8(src, 1024, WGU + ((size_t)e * 2048 + drow) * 2048 + 128 * kb, 2048, scr, F.lane, 64.f);
        } else {
            r -= 2 * I_G; const int kb = r / 32, nb = r % 32;
            p0_tr_item8(F.in[22] + ((size_t)e * 1024 + 128 * kb) * 2048 + 64 * nb, 2048, WDN + ((size_t)e * 2048 + 64 * nb) * 1024 + 128 * kb, 1024, scr, F.lane, 64.f);
        }
    }
    __syncthreads();
}
#endif
namespace att {
constexpr int STG = 32768, NST = 3;
__device__ __forceinline__ unsigned cvtpk(float lo, float hi) { typedef __bf16 bf2 __attribute__((ext_vector_type(2))); f32x2 v = {lo, hi}; bf2 b = __builtin_convertvector(v, bf2); return __builtin_bit_cast(unsigned, b); }
#define ATT_WAITBAR(N) asm volatile("s_waitcnt vmcnt(" #N ") lgkmcnt(0)\n\ts_barrier" ::: "memory")
#define ATT_WAITBAR_L() asm volatile("s_waitcnt lgkmcnt(0)\n\ts_barrier" ::: "memory")
__device__ __forceinline__ void glds16(const char* gbase, unsigned voff, unsigned lds_dst) { unsigned keep;
    asm volatile("s_mov_b32 %0, m0\n\ts_mov_b32 m0, %3\n\ts_nop 0\n\tglobal_load_lds_dwordx4 %1, %2\n\ts_mov_b32 m0, %0" : "=&s"(keep) : "v"(voff), "s"(gbase), "s"(lds_dst) : "memory"); }
#define MFMA32(a, b, c) __builtin_amdgcn_mfma_f32_32x32x16_bf16((a), (b), (c), 0, 0, 0)

#ifndef ATT_WAVESKIP
#define ATT_WAVESKIP 1
#endif
#ifndef ATT_REFINE
#define ATT_REFINE 1
#endif
#ifndef ATT_ROLE
#define ATT_ROLE(wv) (wv)
#endif
constexpr float SKIP_THR = 32.0f;
template <bool CHECK = false>
__device__ __forceinline__ void att_norms(Frame& F) {
    const bf16* P = WSP(bf16, WS_PROJ); float* NRM = WSP(float, WS_NRM);
    LAS float* red = (LAS float*)(F.lds + RING_OFF);
    for (int u = F.vcu; u < NB * 128; u += F.G) {
        const size_t row0 = (size_t)u * 64 + F.wave * 8;
        float mx[4] = {0.f, 0.f, 0.f, 0.f};
#pragma unroll 4
        for (int r = 0; r < 8; ++r) {
            const bf16* rp = P + (row0 + r) * PITCH + 8 * F.lane;
#pragma unroll
            for (int i = 0; i < 4; ++i) { const v4u v = *(const v4u*)(rp + 512 * i); float s = 0.f;
#pragma unroll
                for (int k = 0; k < 4; ++k) { const float a = bflo(v[k]), c = bfhi(v[k]); s += a * a + c * c; }
                s += __shfl_xor(s, 1); s += __shfl_xor(s, 2); s += __shfl_xor(s, 4);
                mx[i] = __builtin_fmaxf(mx[i], s); }
        }
        __syncthreads();
        if ((F.lane & 7) == 0) {
#pragma unroll
            for (int i = 0; i < 4; ++i) red[F.wave * 32 + 8 * i + (F.lane >> 3)] = mx[i]; }
        LDS_WAIT(); __syncthreads();
        if (F.tid < 32) { float m = 0.f;
#pragma unroll
            for (int w = 0; w < 8; ++w) m = __builtin_fmaxf(m, red[w * 32 + F.tid]);
            if (CHECK) { const float t = NRM[(size_t)u * 32 + F.tid]; if (!(__builtin_fabsf(t - m) <= 1e-5f * m)) __hip_atomic_store(F.ctl + CW_CODE, 1u, RLX_AGENT); }
            else NRM[(size_t)u * 32 + F.tid] = m; }
    }
    __syncthreads();
}
struct FtLoads { float a[8], k[4]; };
__device__ __forceinline__ FtLoads att_ft_loads(Frame& F, int b, int h, int qb) {
    const float* NR = WSP(float, WS_NRM) + (size_t)b * 128 * 32;
    const int g0 = 2 * h;
    FtLoads L;
#pragma unroll
    for (int m = 0; m < 2; ++m) {
        L.a[4 * m + 0] = NR[(2 * qb) * 32 + g0 + m];      L.a[4 * m + 1] = NR[(2 * qb + 1) * 32 + g0 + m];
        L.a[4 * m + 2] = NR[(2 * qb) * 32 + 16 + g0 + m]; L.a[4 * m + 3] = NR[(2 * qb + 1) * 32 + 16 + g0 + m]; }
#pragma unroll
    for (int rd = 0; rd < 2; ++rd)
#pragma unroll
        for (int m = 0; m < 2; ++m) L.k[2 * rd + m] = NR[(rd * 64 + F.lane) * 32 + 16 + g0 + m];
    return L;
}
__device__ __forceinline__ int att_ft_eval(const FtLoads& L, Frame& F, int qb, float slope2) {
    float qn[2], kd[2];
#pragma unroll
    for (int m = 0; m < 2; ++m) {
        qn[m] = __builtin_sqrtf(__builtin_fmaxf(L.a[4 * m + 0], L.a[4 * m + 1]));
        kd[m] = __builtin_sqrtf(__builtin_fmaxf(L.a[4 * m + 2], L.a[4 * m + 3])); }
    int j0 = 2 * qb;
#pragma unroll
    for (int rd = 1; rd >= 0; --rd) {
        const int j = rd * 64 + F.lane; bool need = false;
        const float dmin = (float)(128 * qb - 64 * j - 63) * slope2;
#pragma unroll
        for (int m = 0; m < 2; ++m) { const float kn = __builtin_sqrtf(L.k[2 * rd + m]); need = need || (qn[m] * (kn + kd[m]) + SKIP_THR > dmin); }
        need = need && (j < 2 * qb);
        const unsigned long long bal = __ballot(need);
        if (bal) j0 = rd * 64 + (int)__builtin_ctzll(bal);
    }
    return j0;
}

__device__ __forceinline__ int att_ft_eval2(const FtLoads& L, Frame& F, int qb, float slope2, const float (&mmin)[2]) {
    float qn[2];
#pragma unroll
    for (int m = 0; m < 2; ++m) qn[m] = __builtin_sqrtf(__builtin_fmaxf(L.a[4 * m + 0], L.a[4 * m + 1]));
    int j0 = 2 * qb;
#pragma unroll
    for (int rd = 1; rd >= 0; --rd) {
        const int j = rd * 64 + F.lane; bool need = false;
        const float dmin = (float)(128 * qb - 64 * j - 63) * slope2;
#pragma unroll
        for (int m = 0; m < 2; ++m) { const float kn = __builtin_sqrtf(L.k[2 * rd + m]); need = need || (qn[m] * kn - mmin[m] + SKIP_THR > dmin); }
        need = need && (j < 2 * qb);
        const unsigned long long bal = __ballot(need);
        if (bal) j0 = rd * 64 + (int)__builtin_ctzll(bal);
    }
    return j0;
}

struct SteadyArgs { LAS const unsigned char* citab; unsigned kb, vb; float base, base1; bf16x8 q[4]; };
template <int MODE>
__device__ __forceinline__ void att_steady(const SteadyArgs& a, f32x16 (&o)[4], f32x16& c0, f32x16& c1, f32x16& n0, f32x16& n1, v4u (&pw)[4],
                                           float& m_cur, float& al_out, float& ls_out, bool& pv_on) {
#define SB_() __builtin_amdgcn_sched_barrier(0)
#define LP_(x) ((LAS const unsigned char*)(uintptr_t)(x))
#define KF0_(d0) (*(LAS const bf16x8*)(LP_(a.kb ^ (32u * (d0)))))
#define KF1_(d0) (*(LAS const bf16x8*)(LP_(a.kb ^ (32u * (d0))) + 4096))
#define QF_(d0) (a.q[d0])
#define VF_(d, s) __builtin_shufflevector(lds_tr16(LP_(a.vb ^ (64u * (d))) + (s) * 4096), lds_tr16(LP_(a.vb ^ (64u * (d)) ^ 2080u) + (s) * 4096), 0, 1, 2, 3, 4, 5, 6, 7)
#define PVM_(slot, vf) o[(slot) & 3] = MFMA32(vf, __builtin_bit_cast(bf16x8, pw[(slot) >> 2]), o[(slot) & 3])
#define MX_(b) do { mx0 = __builtin_fmaxf(__builtin_fmaxf(mx0, c0[b]), c0[(b) + 1]); mx0 = __builtin_fmaxf(__builtin_fmaxf(mx0, c0[(b) + 2]), c0[(b) + 3]); \
                     mx1 = __builtin_fmaxf(__builtin_fmaxf(mx1, c1[b]), c1[(b) + 1]); mx1 = __builtin_fmaxf(__builtin_fmaxf(mx1, c1[(b) + 2]), c1[(b) + 3]); } while (0)
#define MXROW_() do { float mx = __builtin_fmaxf(mx0 + a.base, mx1 + a.base1); \
      auto rr = __builtin_amdgcn_permlane32_swap(__float_as_uint(mx), __float_as_uint(mx), false, false); mxr = __builtin_fmaxf(__uint_as_float(rr[0]), __uint_as_float(rr[1])); } while (0)
#define CINIT_() do { const f32x4 t0 = *(LAS const f32x4*)(a.citab), t1 = *(LAS const f32x4*)(a.citab + 16), t2 = *(LAS const f32x4*)(a.citab + 32), t3 = *(LAS const f32x4*)(a.citab + 48); \
      n0 = (f32x16){t0.x, t0.y, t0.z, t0.w, t1.x, t1.y, t1.z, t1.w, t2.x, t2.y, t2.z, t2.w, t3.x, t3.y, t3.z, t3.w}; } while (0)
    float mx0 = -1e30f, mx1 = -1e30f, mxr;
    if (pv_on) {
    bf16x8 v0_ = VF_(0, 0), v1_ = VF_(1, 0);
    SB_();
    bf16x8 v2_ = VF_(2, 0), v3_ = VF_(3, 0), v4_ = VF_(0, 1);
    PVM_(0, v0_); PVM_(1, v1_); PVM_(2, v2_);
    MX_(0); MX_(4);
    SB_();
    bf16x8 v5_ = VF_(1, 1), v6_ = VF_(2, 1), v7_ = VF_(3, 1);
    PVM_(3, v3_); PVM_(4, v4_); PVM_(5, v5_);
    MX_(8); MX_(12);
    MXROW_();
    SB_();
    bf16x8 v8_ = VF_(0, 2), v9_ = VF_(1, 2), v10_ = VF_(2, 2);
    PVM_(6, v6_); PVM_(7, v7_); PVM_(8, v8_);
    SB_();
    bf16x8 v11_ = VF_(3, 2), v12_ = VF_(0, 3), v13_ = VF_(1, 3);
    PVM_(9, v9_); PVM_(10, v10_); PVM_(11, v11_);
    SB_();
    bf16x8 v14_ = VF_(2, 3), v15_ = VF_(3, 3), ka0 = KF0_(0), kb0 = KF1_(0), q0_ = QF_(0);
    PVM_(12, v12_); PVM_(13, v13_); PVM_(14, v14_);
    SB_();
    CINIT_();
    bf16x8 ka1 = KF0_(1), kb1 = KF1_(1), q1_ = QF_(1);
    PVM_(15, v15_); n1 = MFMA32(kb0, q0_, n0); n0 = MFMA32(ka0, q0_, n0);
    SB_();
    bf16x8 ka2 = KF0_(2), q2_ = QF_(2);
    n0 = MFMA32(ka1, q1_, n0); n1 = MFMA32(kb1, q1_, n1);
    SB_();
    bf16x8 kb2 = KF1_(2), ka3 = KF0_(3), q3_ = QF_(3);
    n0 = MFMA32(ka2, q2_, n0);
    SB_();
    bf16x8 kb3 = KF1_(3);
    n1 = MFMA32(kb2, q2_, n1); n0 = MFMA32(ka3, q3_, n0); n1 = MFMA32(kb3, q3_, n1);
    SB_();
    } else {
    bf16x8 ka0 = KF0_(0), kb0 = KF1_(0), q0_ = QF_(0);
    CINIT_();
    SB_();
    bf16x8 ka1 = KF0_(1), kb1 = KF1_(1), q1_ = QF_(1);
    n1 = MFMA32(kb0, q0_, n0); n0 = MFMA32(ka0, q0_, n0);
    MX_(0); MX_(4);
    SB_();
    bf16x8 ka2 = KF0_(2), kb2 = KF1_(2), q2_ = QF_(2);
    n0 = MFMA32(ka1, q1_, n0); n1 = MFMA32(kb1, q1_, n1);
    MX_(8); MX_(12);
    MXROW_();
    SB_();
    bf16x8 ka3 = KF0_(3), kb3 = KF1_(3), q3_ = QF_(3);
    n0 = MFMA32(ka2, q2_, n0); n1 = MFMA32(kb2, q2_, n1);
    SB_();
    n0 = MFMA32(ka3, q3_, n0); n1 = MFMA32(kb3, q3_, n1);
    SB_();
    }
    const bool ex_on = !ATT_WAVESKIP || __any(mxr > m_cur - SKIP_THR);
    f32x2 ls2 = {0.f, 0.f};
    if (ex_on) {
    const float mnew = __builtin_fmaxf(m_cur, mxr); al_out = __builtin_amdgcn_exp2f(m_cur - mnew); m_cur = mnew;
    const float sh = a.base - mnew, sh1 = a.base1 - mnew;
    const f32x2 sh2 = {sh, sh}, sh12 = {sh1, sh1};
#pragma unroll
    for (int r = 0; r < 16; r += 2) {
        f32x2 t = (f32x2){c0[r], c0[r + 1]} + sh2;
        t.x = __builtin_amdgcn_exp2f(t.x); t.y = __builtin_amdgcn_exp2f(t.y);
        ls2 += t; c0[r] = t.x; c0[r + 1] = t.y;
    }
#pragma unroll
    for (int r = 0; r < 16; r += 2) {
        f32x2 t = (f32x2){c1[r], c1[r + 1]} + sh12;
        t.x = __builtin_amdgcn_exp2f(t.x); t.y = __builtin_amdgcn_exp2f(t.y);
        ls2 += t; c1[r] = t.x; c1[r + 1] = t.y;
    }
    pw[0] = (v4u){cvtpk(c0[0], c0[1]), cvtpk(c0[2], c0[3]), cvtpk(c0[4], c0[5]), cvtpk(c0[6], c0[7])};
    pw[1] = (v4u){cvtpk(c0[8], c0[9]), cvtpk(c0[10], c0[11]), cvtpk(c0[12], c0[13]), cvtpk(c0[14], c0[15])};
    pw[2] = (v4u){cvtpk(c1[0], c1[1]), cvtpk(c1[2], c1[3]), cvtpk(c1[4], c1[5]), cvtpk(c1[6], c1[7])};
    pw[3] = (v4u){cvtpk(c1[8], c1[9]), cvtpk(c1[10], c1[11]), cvtpk(c1[12], c1[13]), cvtpk(c1[14], c1[15])};
    } else { al_out = 1.0f; }
    ls_out = ls2.x + ls2.y;
    pv_on = ex_on;
#undef SB_
#undef LP_
#undef KF0_
#undef KF1_
#undef QF_
#undef VF_
#undef PVM_
#undef MX_
#undef MXROW_
#undef CINIT_
}

template <int MODE = 0>
__device__ __forceinline__ void attn_unit(Frame& F, int b, int h, int qb, float lam) {
    int lane_ = F.lane; asm volatile("" : "+v"(lane_));
    const int lane = lane_, w = ATT_ROLE(F.wave), g = w >> 1, m = w & 1, r32 = lane & 31, hi = lane >> 5;
    const bf16* __restrict__ P = WSP(bf16, WS_PROJ);
    bf16* MIX = WSP(bf16, WS_XB);
    LAS unsigned char* lds = F.lds + RING_OFF;
    const size_t rowb = (size_t)b * SEQ;
    const int q0 = qb * 128;
    const int t = q0 + 32 * g + r32;
    const float slope2 = __builtin_amdgcn_exp2f(-(float)(h + 1)) * LOG2E;
    const int jmax = 2 * qb + 1, jw = 2 * qb + (g >> 1);
    const char* Pb = (const char*)(P + rowb * PITCH);
#define ATT_KOFFS() unsigned koffA, koffB; { int l_ = lane; asm volatile("" : "+v"(l_)); const int kr = 16 * (w >> 1) + (l_ >> 3), cp = l_ & 7;     \
      const int cA = cp ^ ((kr >> 1) & 7), cB = cp ^ (((kr + 8) >> 1) & 7); \
      koffA = (unsigned)(kr * PITCH + KC + h * 128 + (w & 1) * 64 + cA * 8) * 2u; koffB = (unsigned)((kr + 8) * PITCH + KC + h * 128 + (w & 1) * 64 + cB * 8) * 2u; }
#define ATT_VOFFS() unsigned voffA, voffB; { int l_ = lane; asm volatile("" : "+v"(l_)); const int vr = 8 * w + (l_ >> 4), vp = l_ & 15;                    \
      const int hA = vp ^ (((vr & 3) << 2) | ((vr >> 2) & 3)), hB = vp ^ ((((vr + 4) & 3) << 2) | (((vr + 4) >> 2) & 3)); \
      voffA = (unsigned)(vr * PITCH + VC + h * 128 + hA * 8) * 2u; voffB = (unsigned)((vr + 4) * PITCH + VC + h * 128 + hB * 8) * 2u; }
    const unsigned lds0 = (unsigned)(uintptr_t)lds;
    const unsigned kdst = lds0 + (unsigned)((w & 1) * 8192 + (w >> 1) * 2048), vdst = lds0 + 49152u + (unsigned)(w * 2048);
#define ATT_DMA_K(k) do { if (MODE == 2) break; ATT_KOFFS() const char* tb_ = Pb + (size_t)(jmax - (k)) * (64 * PITCH * 2); const unsigned so_ = (unsigned)((k) % 3) * 16384u; \
        glds16(tb_, koffA, kdst + so_); glds16(tb_, koffB, kdst + so_ + 1024u); } while (0)
#define ATT_DMA_V(k) do { if (MODE == 2) break; ATT_VOFFS() const char* tb_ = Pb + (size_t)(jmax - (k)) * (64 * PITCH * 2); const unsigned so_ = (unsigned)((k) % 3) * 16384u; \
        glds16(tb_, voffA, vdst + so_); glds16(tb_, voffB, vdst + so_ + 1024u); } while (0)
    ATT_DMA_K(0);
    ATT_DMA_K(1);
    LAS unsigned char* qlds = lds + 98304 + w * 4096 + lane * 16;
    int NT_full; FtLoads ftl;
    { const bf16* qp = P + (rowb + t) * PITCH + QC + h * 128 + m * 64 + hi * 8;
      bf16x8 qtmp[4];
#pragma unroll
      for (int d0 = 0; d0 < 4; ++d0) qtmp[d0] = *(const bf16x8*)(qp + d0 * 16);
      ftl = att_ft_loads(F, b, h, qb);
#pragma unroll
      for (int d0 = 0; d0 < 4; ++d0) *(LAS bf16x8*)(qlds + d0 * 1024) = qtmp[d0];
      NT_full = jmax + 1 - att_ft_eval(ftl, F, qb, slope2); }
    int NT = (MODE == 7) ? 2 : NT_full;
    f32x16 o[4];
#pragma unroll
    for (int d = 0; d < 4; ++d)
#pragma unroll
        for (int r = 0; r < 16; ++r) o[d][r] = 0.f;
    LAS float* citab_w = (LAS float*)(F.lds + TAB_OFF + 2048);
    if (w == 0 && lane < 32) citab_w[lane] = slope2 * (float)(((lane & 15) & 3) + 8 * ((lane & 15) >> 2) + 4 * (lane >> 4));
    LAS const unsigned char* citab = (LAS const unsigned char*)citab_w + hi * 64;
    const float c32 = 32.f * slope2;
    float lrun = 0.f;
    const int vad0 = 256 * (4 * hi + ((lane & 15) >> 2)) + 16 * (((((lane & 15) >> 2)) << 2) | ((2 * ((lane >> 4) & 1) + ((lane & 3) >> 1)) ^ hi)) + 8 * (lane & 1);
    const int kad = 128 * r32 + 16 * (hi ^ ((r32 >> 1) & 7));
#define ATT_TOP(i) do { const int i_ = (i); const int cnt_ = 2 * ((i_ + 2) < NT) + 2 * ((i_ + 1) >= 1 && (i_ + 1) <= NT); \
        if (cnt_ == 4) { ATT_WAITBAR(4); } else if (cnt_ == 2) { ATT_WAITBAR(2); } else { ATT_WAITBAR(0); } \
        if (i_ + 3 < NT) ATT_DMA_K(i_ + 3); if (i_ + 1 >= 0 && i_ + 1 < NT) ATT_DMA_V(i_ + 1); } while (0)
#define ATT_SB() __builtin_amdgcn_sched_barrier(0)
#define ATT_LOADCI(dst) do { const f32x4 t0_ = *(LAS const f32x4*)(citab), t1_ = *(LAS const f32x4*)(citab + 16), t2_ = *(LAS const f32x4*)(citab + 32), t3_ = *(LAS const f32x4*)(citab + 48); \
        dst = (f32x16){t0_.x, t0_.y, t0_.z, t0_.w, t1_.x, t1_.y, t1_.z, t1_.w, t2_.x, t2_.y, t2_.z, t2_.w, t3_.x, t3_.y, t3_.z, t3_.w}; } while (0)
#define ATT_QKG(k, DIAG, d0_, d1_) do { LAS const unsigned char* Kb = lds + ((k) % 3) * 16384 + m * 8192; \
        if (DIAG) { d0_ = zero16; d1_ = zero16; } else { ATT_LOADCI(d0_); ATT_LOADCI(d1_); } \
        _Pragma("unroll") for (int d0 = 0; d0 < 4; ++d0) { const bf16x8 kf0 = *(LAS const bf16x8*)(Kb + (kad ^ (32 * d0))), kf1 = *(LAS const bf16x8*)(Kb + (kad ^ (32 * d0)) + 4096), qf = *(LAS const bf16x8*)(qlds + d0 * 1024); \
            d0_ = MFMA32(kf0, qf, d0_); d1_ = MFMA32(kf1, qf, d1_); } } while (0)
#define ATT_PVG(kv, pw_) do { LAS const unsigned char* Vb = lds + 49152 + ((kv) % 3) * 16384; \
        _Pragma("unroll") for (int d = 0; d < 4; ++d) { _Pragma("unroll") for (int s = 0; s < 4; ++s) { \
            const s16x4 lo = lds_tr16(Vb + (vad0 ^ (64 * d)) + s * 4096); const s16x4 hh = lds_tr16(Vb + (vad0 ^ (64 * d) ^ 2080) + s * 4096); \
            o[d] = MFMA32(__builtin_shufflevector(lo, hh, 0, 1, 2, 3, 4, 5, 6, 7), __builtin_bit_cast(bf16x8, pw_[s]), o[d]); } ATT_SB(); } } while (0)
#define ATT_STAGEA(k, DIAG, x0_, x1_) do { const int j = jmax - (k); const int lb = 64 * j - t; float base = 0.f, base1 = 0.f; \
        if (DIAG) { const float lbf = (float)(lb + 4 * hi); \
            _Pragma("unroll") for (int r = 0; r < 16; ++r) { const float off = (float)((r & 3) + 8 * (r >> 2)); \
                x0_[r] = __builtin_fmaf(-slope2, __builtin_fabsf(lbf + off), x0_[r]); x1_[r] = __builtin_fmaf(-slope2, __builtin_fabsf(lbf + off + 32.f), x1_[r]); } } \
        else { base = slope2 * (float)lb; base1 = base + c32; } \
        float mx0 = -1e30f, mx1 = -1e30f; \
        _Pragma("unroll") for (int r = 0; r < 16; ++r) { mx0 = __builtin_fmaxf(mx0, x0_[r]); mx1 = __builtin_fmaxf(mx1, x1_[r]); } \
        float mx = __builtin_fmaxf(mx0 + base, mx1 + base1); \
        { auto rr = __builtin_amdgcn_permlane32_swap(__float_as_uint(mx), __float_as_uint(mx), false, false); mx = __builtin_fmaxf(__uint_as_float(rr[0]), __uint_as_float(rr[1])); } \
        const float mnew = __builtin_fmaxf(m_cur, mx); al_cur = __builtin_amdgcn_exp2f(m_cur - mnew); m_cur = mnew; sh_cur = base - mnew; sh1_cur = base1 - mnew; } while (0)
#define ATT_STAGEB(x0_, x1_, pw_) do { float ls = 0.f; \
        _Pragma("unroll") for (int r = 0; r < 16; ++r) { x0_[r] = __builtin_amdgcn_exp2f(x0_[r] + sh_cur); x1_[r] = __builtin_amdgcn_exp2f(x1_[r] + sh1_cur); ls += x0_[r] + x1_[r]; } \
        pw_[0] = (v4u){cvtpk(x0_[0], x0_[1]), cvtpk(x0_[2], x0_[3]), cvtpk(x0_[4], x0_[5]), cvtpk(x0_[6], x0_[7])}; \
        pw_[1] = (v4u){cvtpk(x0_[8], x0_[9]), cvtpk(x0_[10], x0_[11]), cvtpk(x0_[12], x0_[13]), cvtpk(x0_[14], x0_[15])}; \
        pw_[2] = (v4u){cvtpk(x1_[0], x1_[1]), cvtpk(x1_[2], x1_[3]), cvtpk(x1_[4], x1_[5]), cvtpk(x1_[6], x1_[7])}; \
        pw_[3] = (v4u){cvtpk(x1_[8], x1_[9]), cvtpk(x1_[10], x1_[11]), cvtpk(x1_[12], x1_[13]), cvtpk(x1_[14], x1_[15])}; \
        lrun = lrun * al_cur + ls; ATT_RESCALE(); } while (0)
#define ATT_RESCALE() do { if (__any(al_cur != 1.0f)) { _Pragma("unroll") for (int d = 0; d < 4; ++d) _Pragma("unroll") for (int r = 0; r < 16; ++r) o[d][r] *= al_cur; } } while (0)
    f32x16 zero16;
#pragma unroll
    for (int r = 0; r < 16; ++r) zero16[r] = 0.f;
    f32x16 sA0, sA1, sB0, sB1; v4u pwB[4];
    float m_cur = -1e30f, al_cur = 1.0f, sh_cur = 0.f, sh1_cur = 0.f;
    const bool act0 = (jmax <= jw);
    if (MODE == 0 || MODE >= 7) {
    ATT_TOP(-1); if (act0) ATT_QKG(0, true, sA0, sA1);
    ATT_TOP(0);  if (act0) { ATT_QKG(1, false, sB0, sB1); } else { ATT_QKG(1, true, sB0, sB1); }
                 if (act0) { ATT_STAGEA(0, true, sA0, sA1); ATT_STAGEB(sA0, sA1, pwB); }
    ATT_TOP(1);  if (act0) ATT_PVG(0, pwB);
                 if (2 < NT) ATT_QKG(2, false, sA0, sA1);
                 if (act0) { ATT_STAGEA(1, false, sB0, sB1); } else { ATT_STAGEA(1, true, sB0, sB1); }
                 ATT_STAGEB(sB0, sB1, pwB);
    if (ATT_REFINE && NT > 3) {
        float wm = m_cur;
#pragma unroll
        for (int o_ = 1; o_ < 64; o_ <<= 1) wm = __builtin_fminf(wm, __shfl_xor(wm, o_));
        LAS float* exm = (LAS float*)(F.lds + TAB_OFF + 2048 + 256);
        if (lane == 0) exm[w] = wm;
        ATT_WAITBAR_L();
        float mmin[2];
        mmin[0] = __builtin_fminf(__builtin_fminf(exm[0], exm[2]), __builtin_fminf(exm[4], exm[6]));
        mmin[1] = __builtin_fminf(__builtin_fminf(exm[1], exm[3]), __builtin_fminf(exm[5], exm[7]));
        const int nt2 = jmax + 1 - att_ft_eval2(ftl, F, qb, slope2, mmin);
        NT = nt2 < 3 ? 3 : (nt2 < NT ? nt2 : NT);
    }
    int i = 2;
    bool pv_on = true;
    SteadyArgs sa; sa.citab = citab;
#pragma unroll
    for (int d0 = 0; d0 < 4; ++d0) sa.q[d0] = *(LAS const bf16x8*)(qlds + d0 * 1024);
#define ATT_STEADY(i_, C0, C1, N0, N1, PW) do { const int ii = (i_); \
        { unsigned kb_ = lds0 + (unsigned)(((ii + 1) % 3) * 16384 + m * 8192 + kad), vb_ = lds0 + 49152u + (unsigned)(((ii - 1) % 3) * 16384 + vad0); \
          asm volatile("" : "+v"(kb_), "+v"(vb_)); sa.kb = kb_; sa.vb = vb_; } \
        sa.base = slope2 * (float)(64 * (jmax - ii) - t); sa.base1 = sa.base + c32; \
        float ls_; att_steady<MODE>(sa, o, C0, C1, N0, N1, PW, m_cur, al_cur, ls_, pv_on); \
        lrun = lrun * al_cur + ls_; ATT_RESCALE(); } while (0)
    for (; i <= NT - 2; ++i) { ATT_TOP(i); ATT_STEADY(i, sA0, sA1, sB0, sB1, pwB); sA0 = sB0; sA1 = sB1; }
    if (NT >= 3) { ATT_TOP(NT - 1); if (pv_on) ATT_PVG(NT - 2, pwB); ATT_STAGEA(NT - 1, false, sA0, sA1); ATT_STAGEB(sA0, sA1, pwB); ATT_TOP(NT); ATT_PVG(NT - 1, pwB); }
    else { ATT_TOP(2); ATT_PVG(1, pwB); }
    }
    float mrun = m_cur; (void)mrun;
#undef ATT_TOP
#undef ATT_SB
#undef ATT_LOADCI
#undef ATT_QKG
#undef ATT_PVG
#undef ATT_STAGEA
#undef ATT_STAGEB
#undef ATT_RESCALE
#undef ATT_STEADY
    { auto rr = __builtin_amdgcn_permlane32_swap(__float_as_uint(lrun), __float_as_uint(lrun), false, false); lrun = __uint_as_float(rr[0]) + __uint_as_float(rr[1]); }
    const float inv = 1.0f / lrun;
    ATT_WAITBAR(0);
    int lane2 = lane; asm volatile("" : "+v"(lane2));
    const int hi2 = lane2 >> 5, t2 = q0 + 32 * g + (lane2 & 31);
    LAS float* ex = (LAS float*)(lds + g * 16384) + lane2;
    if (m == 1) {
#pragma unroll
        for (int d = 0; d < 4; ++d)
#pragma unroll
            for (int r = 0; r < 16; ++r) ex[(d * 16 + r) * 64] = o[d][r] * inv;
    }
    ATT_WAITBAR(0);
    if (m == 0) {
        float ss = 0.f;
#pragma unroll
        for (int d = 0; d < 4; ++d) {
#pragma unroll
            for (int r = 0; r < 16; ++r) { const float v = o[d][r] * inv - lam * ex[(d * 16 + r) * 64]; o[d][r] = v; ss += v * v; }
            __builtin_amdgcn_sched_barrier(0);
        }
        { auto rr = __builtin_amdgcn_permlane32_swap(__float_as_uint(ss), __float_as_uint(ss), false, false); ss = __uint_as_float(rr[0]) + __uint_as_float(rr[1]); }
        const float rs = 0.8f / __builtin_sqrtf(ss * (1.0f / 128.0f) + RMS_EPS);
        const float* nw = F.in[6] + 4 * hi2;
        bf16* orow = MIX + (rowb + t2) * DM + h * 128 + 4 * hi2;
#pragma unroll
        for (int d = 0; d < 4; ++d) {
#pragma unroll
            for (int gq = 0; gq < 4; ++gq) {
                const int dc = 32 * d + 8 * gq;
                const f32x4 nv = *(const f32x4*)(nw + dc);
                v2u ov; ov.x = cvtpk(o[d][4 * gq] * rs * nv.x, o[d][4 * gq + 1] * rs * nv.y); ov.y = cvtpk(o[d][4 * gq + 2] * rs * nv.z, o[d][4 * gq + 3] * rs * nv.w);
                if (MODE == 0) *(v2u*)(orow + dc) = ov;
            }
            __builtin_amdgcn_sched_barrier(0);
        }
    }
    ATT_WAITBAR(0);
#undef ATT_DMA_K
#undef ATT_KOFFS
#undef ATT_VOFFS
#undef ATT_DMA_V
}
}
namespace ssd {
#define MFMA16(a, b, c) __builtin_amdgcn_mfma_f32_16x16x32_bf16((a), (b), (c), 0, 0, 0)
constexpr int XT_P = 72;
constexpr int NAT_P = 136;
constexpr int L_TAB = 0;
constexpr int L_BT = 8192;
constexpr int L_CN = L_BT + 18432;
constexpr int L_XT = L_CN + 17408;
static_assert(L_XT + 8 * 9216 <= 131072, "ssd lds");

__device__ __forceinline__ float silu(float v) { return v * __builtin_amdgcn_rcpf(1.0f + __builtin_amdgcn_exp2f(-v * LOG2E)); }
__device__ __forceinline__ float softplus(float v) { return __builtin_fmaxf(v, 0.f) + log1pf(__expf(-__builtin_fabsf(v))); }

__device__ __forceinline__ float dt_tables(Frame& F, int b, int c, int g2) {
    const int hd = 8 * g2 + F.wave, l = F.lane;
    const float* DT = WSP(float, WS_DT);
    const float dtr = DT[((size_t)b * SEQ + 64 * c + l) * 16 + hd] + F.in[9][hd];
    const float dt = softplus(dtr);
    const float a = -__expf(F.in[10][hd]);
    float v = dt * a;
#pragma unroll
    for (int off = 1; off < 64; off <<= 1) { const float y = __shfl_up(v, off); if (l >= off) v += y; }
    LAS float* tab = (LAS float*)(F.lds + RING_OFF + L_TAB);
    const float tot = __shfl(v, 63);
    tab[F.wave * 64 + l] = dt; tab[512 + F.wave * 64 + l] = v; tab[1536 + F.wave * 64 + l] = dt * __expf(tot - v);
    return tot;
}

template <int NR> struct ConvIn { unsigned raw[NR + 3]; float w0[4], w1[4], b0, b1; };
template <int NR>
__device__ __forceinline__ void conv_load(Frame& F, int b, int c, int col, int l0, ConvIn<NR>& R) {
    const bf16* P = WSP(bf16, WS_PROJ);
    const float* cw = F.in[7]; const float* cb = F.in[8];
    const int cch = col - XC;
#pragma unroll
    for (int k = 0; k < 4; ++k) { R.w0[k] = cw[k * 1536 + cch]; R.w1[k] = cw[k * 1536 + cch + 1]; }
    R.b0 = cb[cch]; R.b1 = cb[cch + 1];
    const int tl0 = 64 * c + l0;
    const bf16* src = P + ((size_t)b * SEQ + tl0) * PITCH + col;
#pragma unroll
    for (int k = 0; k < 3; ++k) { R.raw[k] = 0u; if (tl0 - 3 + k >= 0) R.raw[k] = *(const unsigned*)(src + (ptrdiff_t)(k - 3) * PITCH); }
#pragma unroll
    for (int i = 0; i < NR; ++i) R.raw[3 + i] = *(const unsigned*)(src + (size_t)i * PITCH);
}
template <int NR, class Emit>
__device__ __forceinline__ void conv_run(const ConvIn<NR>& R, int l0, Emit&& emit) {
    float xa[3], xb_[3];
#pragma unroll
    for (int k = 0; k < 3; ++k) { xa[k] = bflo(R.raw[k]); xb_[k] = bfhi(R.raw[k]); }
#pragma unroll
    for (int i = 0; i < NR; ++i) {
        const float c0 = bflo(R.raw[3 + i]), c1 = bfhi(R.raw[3 + i]);
        const float y0 = R.b0 + R.w0[0] * xa[0] + R.w0[1] * xa[1] + R.w0[2] * xa[2] + R.w0[3] * c0;
        const float y1 = R.b1 + R.w1[0] * xb_[0] + R.w1[1] * xb_[1] + R.w1[2] * xb_[2] + R.w1[3] * c1;
        xa[0] = xa[1]; xa[1] = xa[2]; xa[2] = c0; xb_[0] = xb_[1]; xb_[1] = xb_[2]; xb_[2] = c1;
        emit(l0 + i, silu(y0), silu(y1));
    }
}

__device__ __forceinline__ void ssd_a_unit(Frame& F, int b, int c, int g2) {
    LAS unsigned char* lds = F.lds + RING_OFF;
    LAS float* tab = (LAS float*)(lds + L_TAB);
    int tid = F.tid; asm volatile("" : "+v"(tid));
    const int cp1 = tid % 320, l01 = (tid / 320) * 32;
    const int t2 = 512 + (tid & 127), cp2 = t2 % 320, l02 = (t2 / 320) * 32 + 8 * (tid >> 7);
    auto acol = [&](int cp) __attribute__((always_inline)) { return (cp < 256) ? XC + g2 * 512 + 2 * cp : XC + 1024 + g2 * 128 + 2 * (cp - 256); };
    ConvIn<32> R1; ConvIn<8> R2;
    conv_load<32>(F, b, c, acol(cp1), l01, R1); conv_load<8>(F, b, c, acol(cp2), l02, R2);
    const float tot = dt_tables(F, b, c, g2);
    if (F.lane == 63) WSP(float, WS_CD)[((size_t)b * 128 + c) * 16 + 8 * g2 + F.wave] = __expf(tot);
    LDS_WAIT(); __syncthreads();
    {
        unsigned* cvrow = (unsigned*)(WSP(bf16, WS_CONV) + ((size_t)b * SEQ + 64 * c) * 1280);
        auto run = [&](auto& R, int cp, int l0) __attribute__((always_inline)) {
            if (cp < 256) {
                const int ch = 2 * cp, hw = ch >> 6, p = ch & 63;
                LAS bf16* xt = (LAS bf16*)(lds + L_XT + hw * 9216);
                unsigned* cv = cvrow + (g2 * 512 + ch) / 2;
                conv_run(R, l0, [&](int l, float v0, float v1) {
                    const float sc = tab[1536 + hw * 64 + l];
                    cv[(size_t)l * 640] = pk2(v0, v1);
                    xt[p * XT_P + l] = (bf16)f2bf(v0 * sc); xt[(p + 1) * XT_P + l] = (bf16)f2bf(v1 * sc); });
            } else {
                const int n = 2 * (cp - 256);
                LAS bf16* bt = (LAS bf16*)(lds + L_BT);
                unsigned* cv = cvrow + (1024 + g2 * 128 + n) / 2;
                conv_run(R, l0, [&](int l, float v0, float v1) { const unsigned pk = pk2(v0, v1); cv[(size_t)l * 640] = pk; bt[n * XT_P + l] = (bf16)(pk & 0xffffu); bt[(n + 1) * XT_P + l] = (bf16)(pk >> 16); });
            }
        };
        __builtin_amdgcn_sched_barrier(0);
        run(R1, cp1, l01);
        __builtin_amdgcn_sched_barrier(0);
        run(R2, cp2, l02);
    }
    LDS_WAIT(); __syncthreads();
    {
        const int r = F.lane & 15, kq = F.lane >> 4, hd = 8 * g2 + F.wave;
        LAS const unsigned char* bt = lds + L_BT + (r * XT_P + 8 * kq) * 2;
        LAS const unsigned char* xt = lds + L_XT + F.wave * 9216 + (r * XT_P + 8 * kq) * 2;
        bf16* ST = (bf16*)F.out + ((((size_t)b * 128 + c) * 16 + hd) * 64) * 128;
#pragma unroll
        for (int nh = 0; nh < 2; ++nh) {
            f32x4 acc[4][4];
#pragma unroll
            for (int i = 0; i < 4; ++i)
#pragma unroll
                for (int j = 0; j < 4; ++j) acc[i][j] = (f32x4){0.f, 0.f, 0.f, 0.f};
#pragma unroll
            for (int ks = 0; ks < 2; ++ks) {
                bf16x8 af[4], bf_[4];
#pragma unroll
                for (int i = 0; i < 4; ++i) { af[i] = *(LAS const bf16x8*)(bt + ((nh * 4 + i) * 16 * XT_P + 32 * ks) * 2); bf_[i] = *(LAS const bf16x8*)(xt + (i * 16 * XT_P + 32 * ks) * 2); }
#pragma unroll
                for (int i = 0; i < 4; ++i)
#pragma unroll
                    for (int j = 0; j < 4; ++j) acc[i][j] = MFMA16(af[i], bf_[j], acc[i][j]);
            }
#pragma unroll
            for (int i = 0; i < 4; ++i)
#pragma unroll
                for (int j = 0; j < 4; ++j) {
                    const int n = (nh * 4 + i) * 16 + 4 * kq, p = 16 * j + r;
                    v2u o; o.x = pk2(acc[i][j].x, acc[i][j].y); o.y = pk2(acc[i][j].z, acc[i][j].w);
                    *(v2u*)(ST + (size_t)p * 128 + n) = o;
                }
        }
    }
    LDS_WAIT(); __syncthreads();
}

__device__ __forceinline__ void ssd_b_item(Frame& F, int item, size_t st_off = 0) {
    bf16* ST = (bf16*)F.out + st_off; const float* CD = WSP(float, WS_CD);
    static_assert(NB * 16 * 64 * 32 == 256 * NWAVES * 64, "ssd_b items");
    {
        const int gid = item * (NWAVES * 64) + F.tid;
        const int n4 = gid & 31, p = (gid >> 5) & 63, hd = (gid >> 11) & 15, b = gid >> 15;
        bf16* ptr = ST + ((((size_t)b * 128) * 16 + hd) * 64 + p) * 128 + 4 * n4;
        const float* cd = CD + (size_t)b * 128 * 16 + hd;
        float h0 = 0.f, h1 = 0.f, h2 = 0.f, h3 = 0.f;
#pragma unroll 16
        for (int c = 0; c < 128; ++c) {
            v2u* q = (v2u*)(ptr + (size_t)c * (16 * 64 * 128));
            const v2u v = *q; const float d = cd[c * 16];
            v2u o; o.x = pk2(h0, h1); o.y = pk2(h2, h3); *q = o;
            h0 = h0 * d + bflo(v.x); h1 = h1 * d + bfhi(v.x); h2 = h2 * d + bflo(v.y); h3 = h3 * d + bfhi(v.y);
        }
    }
}
__device__ __forceinline__ void ssd_b_queue(Frame& F) {
    volatile LAS unsigned* slot = F.MISC + 18;
    for (;;) {
        __syncthreads();
        if (F.tid == 0) *slot = __hip_atomic_fetch_add(F.ctl + CW_SBQ, 1u, RLX_AGENT);
        __syncthreads();
        const unsigned it = *slot;
        if (it >= 256u) break;
        ssd_b_item(F, (int)it);
        VM_WAIT(); __syncthreads();
        if (F.tid == 0) { __builtin_amdgcn_fence(__ATOMIC_RELEASE, "agent"); (void)__hip_atomic_fetch_add(F.ctl + CW_SBDONE, 1u, RLX_AGENT); }
    }
}

__device__ __forceinline__ void ssd_c_unit(Frame& F, int b, int c, int g2) {
    LAS unsigned char* lds = F.lds + RING_OFF;
    LAS float* tab = (LAS float*)(lds + L_TAB);
    int tid = F.tid; asm volatile("" : "+v"(tid));
    const int cp1 = tid % 320, l01 = (tid / 320) * 32;
    const int t2 = 512 + (tid & 127), cp2 = t2 % 320, l02 = (t2 / 320) * 32 + 8 * (tid >> 7);
    const int cpc = tid & 63, l0c = 32 * ((tid >> 6) & 1) + 8 * (tid >> 7);
    auto cch = [&](int cp) __attribute__((always_inline)) { return (cp < 256) ? g2 * 512 + 2 * cp : 1024 + g2 * 128 + 2 * (cp - 256); };
    const unsigned* cvrow = (const unsigned*)(WSP(bf16, WS_CONV) + ((size_t)b * SEQ + 64 * c) * 1280);
    unsigned c1[32], c2[8];
    { const unsigned* s1 = cvrow + (size_t)l01 * 640 + cch(cp1) / 2; const unsigned* s2 = cvrow + (size_t)l02 * 640 + cch(cp2) / 2;
#pragma unroll
      for (int i = 0; i < 32; ++i) c1[i] = s1[(size_t)i * 640];
#pragma unroll
      for (int i = 0; i < 8; ++i) c2[i] = s2[(size_t)i * 640]; }
    ConvIn<8> R3;
    conv_load<8>(F, b, c, XC + 1280 + g2 * 128 + 2 * cpc, l0c, R3);
    bf16x8 pfa[2][4];
    { const int r_ = F.lane & 15, kq_ = F.lane >> 4;
      const bf16* PREV = (const bf16*)F.out + ((((size_t)b * 128 + c) * 16 + 8 * g2 + F.wave) * 64) * 128;
#pragma unroll
      for (int ks = 0; ks < 2; ++ks)
#pragma unroll
          for (int i = 0; i < 4; ++i) pfa[ks][i] = *(const bf16x8*)(PREV + (size_t)(16 * i + r_) * 128 + 32 * ks + 8 * kq_); }
    (void)dt_tables(F, b, c, g2);
    LDS_WAIT(); __syncthreads();
    {
        auto place = [&](const unsigned* v, int nrow, int cp, int l0) __attribute__((always_inline)) {
            if (cp < 256) {
                const int ch = 2 * cp, hw = ch >> 6, p = ch & 63;
                LAS bf16* xt = (LAS bf16*)(lds + L_XT + hw * 9216);
                for (int i = 0; i < nrow; ++i) { const int l = l0 + i; const float sc = tab[hw * 64 + l];
                    xt[p * XT_P + l] = (bf16)f2bf(bflo(v[i]) * sc); xt[(p + 1) * XT_P + l] = (bf16)f2bf(bfhi(v[i]) * sc); }
            } else {
                const int n = 2 * (cp - 256);
                LAS unsigned* bn = (LAS unsigned*)(lds + L_BT);
                for (int i = 0; i < nrow; ++i) bn[((l0 + i) * NAT_P + n) >> 1] = v[i];
            }
        };
        __builtin_amdgcn_sched_barrier(0);
        if (cp1 < 256) {
#pragma unroll
            for (int i = 0; i < 32; ++i) { unsigned one[1] = {c1[i]}; place(one, 1, cp1, l01 + i); }
        } else {
#pragma unroll
            for (int i = 0; i < 32; ++i) { unsigned one[1] = {c1[i]}; place(one, 1, cp1, l01 + i); }
        }
        __builtin_amdgcn_sched_barrier(0);
#pragma unroll
        for (int i = 0; i < 8; ++i) { unsigned one[1] = {c2[i]}; place(one, 1, cp2, l02 + i); }
        __builtin_amdgcn_sched_barrier(0);
        { const int n = 2 * cpc; LAS unsigned* cn = (LAS unsigned*)(lds + L_CN);
          conv_run(R3, l0c, [&](int l, float v0, float v1) { cn[(l * NAT_P + n) >> 1] = pk2(v0, v1); }); }
    }
    LDS_WAIT(); __syncthreads();
    const int r = F.lane & 15, kq = F.lane >> 4, w = F.wave, hd = 8 * g2 + w;
    LAS const unsigned char* bnp = lds + L_BT + (r * NAT_P + 8 * kq) * 2;
    LAS const unsigned char* cnp = lds + L_CN + (r * NAT_P + 8 * kq) * 2;
    f32x4 cb[4][4];
#pragma unroll
    for (int i = 0; i < 4; ++i)
#pragma unroll
        for (int j = 0; j < 4; ++j) cb[i][j] = (f32x4){0.f, 0.f, 0.f, 0.f};
    f32x4 acc[4][4];
#pragma unroll
    for (int i = 0; i < 4; ++i)
#pragma unroll
        for (int j = 0; j < 4; ++j) acc[i][j] = (f32x4){0.f, 0.f, 0.f, 0.f};
    const bf16* PREV = (const bf16*)F.out + ((((size_t)b * 128 + c) * 16 + hd) * 64) * 128;
#pragma unroll
    for (int ks = 0; ks < 4; ++ks) {
        bf16x8 bfr[4], cfr[4], pfr[4];
#pragma unroll
        for (int i = 0; i < 4; ++i) { bfr[i] = *(LAS const bf16x8*)(bnp + (i * 16 * NAT_P + 32 * ks) * 2); cfr[i] = *(LAS const bf16x8*)(cnp + (i * 16 * NAT_P + 32 * ks) * 2);
            if (ks < 2) pfr[i] = pfa[ks][i]; else pfr[i] = *(const bf16x8*)(PREV + (size_t)(16 * i + r) * 128 + 32 * ks + 8 * kq); }
#pragma unroll
        for (int ts = 0; ts < 4; ++ts)
#pragma unroll
            for (int tl = 0; tl < 4; ++tl) { if (ts <= tl) cb[ts][tl] = MFMA16(bfr[ts], cfr[tl], cb[ts][tl]); }
#pragma unroll
        for (int tp = 0; tp < 4; ++tp)
#pragma unroll
            for (int tl = 0; tl < 4; ++tl) acc[tp][tl] = MFMA16(pfr[tp], cfr[tl], acc[tp][tl]);
    }
    float acl[4];
#pragma unroll
    for (int tl = 0; tl < 4; ++tl) acl[tl] = tab[512 + w * 64 + 16 * tl + r];
#pragma unroll
    for (int tp = 0; tp < 4; ++tp)
#pragma unroll
        for (int tl = 0; tl < 4; ++tl) { const float od = __expf(acl[tl]); acc[tp][tl] = acc[tp][tl] * od; }
    const float dsk = F.in[11][hd];
    bf16x8 mf[2][4];
#pragma unroll
    for (int tl = 0; tl < 4; ++tl)
#pragma unroll
        for (int u = 0; u < 2; ++u) {
            unsigned pk[4];
#pragma unroll
            for (int half = 0; half < 2; ++half) {
                const int ts = 2 * u + half; float mv[4];
#pragma unroll
                for (int rg = 0; rg < 4; ++rg) {
                    float val = 0.f;
                    if (ts <= tl) {
                        const int s = 16 * ts + 4 * kq + rg, l = 16 * tl + r;
                        const float as = tab[512 + w * 64 + s];
                        val = (s <= l) ? cb[ts][tl][rg] * __expf(acl[tl] - as) : 0.f;
                        if (s == l) val += dsk / tab[w * 64 + l];
                    }
                    mv[rg] = val;
                }
                pk[half * 2] = pk2(mv[0], mv[1]); pk[half * 2 + 1] = pk2(mv[2], mv[3]);
            }
            v4u t4 = {pk[0], pk[1], pk[2], pk[3]}; mf[u][tl] = __builtin_bit_cast(bf16x8, t4);
        }
    LAS const unsigned char* xtp = lds + L_XT + w * 9216 + (r * XT_P + 4 * kq) * 2;
#pragma unroll
    for (int u = 0; u < 2; ++u) {
        bf16x8 xf[4];
#pragma unroll
        for (int tp = 0; tp < 4; ++tp) { const v2u lo = *(LAS const v2u*)(xtp + (tp * 16 * XT_P + 32 * u) * 2); const v2u hi2 = *(LAS const v2u*)(xtp + (tp * 16 * XT_P + 32 * u + 16) * 2);
            v4u t4 = {lo.x, lo.y, hi2.x, hi2.y}; xf[tp] = __builtin_bit_cast(bf16x8, t4); }
#pragma unroll
        for (int tp = 0; tp < 4; ++tp)
#pragma unroll
            for (int tl = 0; tl < 4; ++tl) { if (2 * u <= tl) acc[tp][tl] = MFMA16(xf[tp], mf[u][tl], acc[tp][tl]); }
    }
    const bf16* P = WSP(bf16, WS_PROJ);
    float ssq[4] = {0.f, 0.f, 0.f, 0.f};
#pragma unroll
    for (int tl = 0; tl < 4; ++tl) {
        const size_t trow = (size_t)b * SEQ + 64 * c + 16 * tl + r;
#pragma unroll
        for (int tp = 0; tp < 4; ++tp) {
            const v2u zv = *(const v2u*)(P + trow * PITCH + ZC + hd * 64 + 16 * tp + 4 * kq);
            f32x4 y = acc[tp][tl];
            y.x *= silu(bflo(zv.x)); y.y *= silu(bfhi(zv.x)); y.z *= silu(bflo(zv.y)); y.w *= silu(bfhi(zv.y));
            acc[tp][tl] = y; ssq[tl] += y.x * y.x + y.y * y.y + y.z * y.z + y.w * y.w;
        }
    }
#pragma unroll
    for (int tl = 0; tl < 4; ++tl) { ssq[tl] += __shfl_xor(ssq[tl], 16); ssq[tl] += __shfl_xor(ssq[tl], 32); if (kq == 0) tab[1024 + w * 64 + 16 * tl + r] = ssq[tl]; }
    LDS_WAIT(); __syncthreads();
    bf16* MIX = WSP(bf16, WS_XB);
    const float* nw = F.in[12] + hd * 64;
#pragma unroll
    for (int tl = 0; tl < 4; ++tl) {
        float tot = 0.f;
#pragma unroll
        for (int ww = 0; ww < 8; ++ww) tot += tab[1024 + ww * 64 + 16 * tl + r];
        const float rs = 1.0f / __builtin_sqrtf(tot * (1.0f / 512.0f) + RMS_EPS);
        const size_t trow = (size_t)b * SEQ + 64 * c + 16 * tl + r;
#pragma unroll
        for (int tp = 0; tp < 4; ++tp) {
            const f32x4 nv = *(const f32x4*)(nw + 16 * tp + 4 * kq);
            const f32x4 y = acc[tp][tl];
            v2u o; o.x = pk2(y.x * rs * nv.x, y.y * rs * nv.y); o.y = pk2(y.z * rs * nv.z, y.w * rs * nv.w);
            *(v2u*)(MIX + trow * DM + 1024 + hd * 64 + 16 * tp + 4 * kq) = o;
        }
    }
    LDS_WAIT(); __syncthreads();
}
__device__ __forceinline__ void ssd_c_queue(Frame& F) {
    volatile LAS unsigned* slot = F.MISC + 19;
    if (F.tid == 0) {
        unsigned sp = 0u;
        while (__hip_atomic_load(F.ctl + CW_SBDONE, RLX_AGENT) < 256u) { __builtin_amdgcn_s_sleep(8); if (++sp > (1u << 22)) break; }
        __builtin_amdgcn_fence(__ATOMIC_ACQUIRE, "agent");
    }
    for (;;) {
        __syncthreads();
        if (F.tid == 0) *slot = __hip_atomic_fetch_add(F.ctl + CW_SCQ, 1u, RLX_AGENT);
        __syncthreads();
        const unsigned u = *slot;
        if (u >= (unsigned)(NB * 128 * 2)) break;
        ssd_c_unit(F, (int)(u >> 8), (int)((u >> 1) & 127u), (int)(u & 1u));
    }
}
}
using pg8::UnitP; using pg8::cvt_pk_bf16;
struct EpiProj {
    static constexpr bool PERM = true;
    bf16* O; float* NRM; LAS float* ex;
    __device__ __forceinline__ void operator()(const f32x4 (&acc)[2][2][4][2], const UnitP& u, int wr, int wc, int fr, int fq) const {
        const float sc = (u.aux < 4) ? QSCALE : 1.f;
        const bool nrm = u.aux < 8;
        const int row0 = u.row0 + wr * 64 + fr, col0 = u.col0 + wc * 32 + 8 * fq;
        const int wid = wr * 4 + wc;
#pragma unroll
        for (int ai = 0; ai < 2; ++ai)
#pragma unroll
            for (int m = 0; m < 4; ++m) { bf16* rowp = O + (size_t)(row0 + ai * 128 + m * 16) * PITCH + col0;
#pragma unroll
                for (int bj = 0; bj < 2; ++bj) { const f32x4 v0 = acc[ai][bj][m][0] * sc, v1 = acc[ai][bj][m][1] * sc;
                    v4u w; w.x = cvt_pk_bf16(v0[0], v0[1]); w.y = cvt_pk_bf16(v0[2], v0[3]); w.z = cvt_pk_bf16(v1[0], v1[1]); w.w = cvt_pk_bf16(v1[2], v1[3]);
                    *(v4u*)(rowp + bj * 128) = w;
                    if (nrm) { float s = 0.f;
#pragma unroll
                        for (int k = 0; k < 4; ++k) { const float a = bflo(w[k]), c = bfhi(w[k]); s += a * a + c * c; }
                        s += __shfl_xor(s, 16); s += __shfl_xor(s, 32);
                        if (fq == 0) ex[wid * 256 + ((ai * 2 + bj) * 4 + m) * 16 + fr] = s; } } }
        if (nrm) {
            LDS_WAIT(); __builtin_amdgcn_s_barrier();
            const int bj = wc & 1;
#pragma unroll
            for (int ai = 0; ai < 2; ++ai) {
                const int idx = ((ai * 2 + bj) * 4 + fq) * 16 + fr;
                float s = ex[wid * 256 + idx] + ex[(wid ^ 1) * 256 + idx];
#pragma unroll
                for (int o = 1; o < 64; o <<= 1) s = __builtin_fmaxf(s, __shfl_xor(s, o));
                if (fr == 0 && fq == 0) NRM[(size_t)(u.row0 / 64 + 2 * ai + wr) * 32 + u.col0 / 64 + 2 * bj + (wc >> 1)] = s;
            }
        }
    }
};
struct EpiRes {
    static constexpr bool PERM = true;
    const float* X; bf16* Y; f32x2* STAT;
    __device__ __forceinline__ void operator()(const f32x4 (&acc)[2][2][4][2], const UnitP& u, int wr, int wc, int fr, int fq) const {
        const int col0 = u.col0 + wc * 32 + 8 * fq;
#pragma unroll
        for (int ai = 0; ai < 2; ++ai)
#pragma unroll
            for (int m = 0; m < 4; ++m) { const int r = u.row0 + ai * 128 + wr * 64 + m * 16 + fr; const size_t off = (size_t)r * DM + col0; float s = 0.f, q = 0.f;
#pragma unroll
                for (int bj = 0; bj < 2; ++bj) {
                    const f32x4 x0 = *(const f32x4*)(X + off + bj * 128), x1 = *(const f32x4*)(X + off + bj * 128 + 4);
                    const f32x4 v0 = x0 * DN_ALPHA + acc[ai][bj][m][0], v1 = x1 * DN_ALPHA + acc[ai][bj][m][1];
                    v4u w; w.x = cvt_pk_bf16(v0[0], v0[1]); w.y = cvt_pk_bf16(v0[2], v0[3]); w.z = cvt_pk_bf16(v1[0], v1[1]); w.w = cvt_pk_bf16(v1[2], v1[3]);
                    *(v4u*)(Y + off + bj * 128) = w;
                    s += (v0.x + v0.y) + (v0.z + v0.w) + (v1.x + v1.y) + (v1.z + v1.w);
                    q += (v0.x * v0.x + v0.y * v0.y) + (v0.z * v0.z + v0.w * v0.w) + (v1.x * v1.x + v1.y * v1.y) + (v1.z * v1.z + v1.w * v1.w); }
                s += __shfl_xor(s, 16); s += __shfl_xor(s, 32); q += __shfl_xor(q, 16); q += __shfl_xor(q, 32);
                if (fq == 0) STAT[(size_t)r * 32 + u.aux * 4 + wc] = (f32x2){s, q}; }
    }
};
__device__ __forceinline__ float silu_f(float v) { return v * __builtin_amdgcn_rcpf(1.0f + __builtin_amdgcn_exp2f(-v * LOG2E)); }
struct EpiGU {
    static constexpr bool PERM = true;
    bf16* H;
    __device__ __forceinline__ void operator()(const f32x4 (&acc)[2][2][4][2], const UnitP& u, int wr, int wc, int fr, int fq) const {
        const int row0 = u.row0 + wr * 64 + fr, col0 = u.col0 + wc * 32 + 8 * fq;
#pragma unroll
        for (int ai = 0; ai < 2; ++ai)
#pragma unroll
            for (int m = 0; m < 4; ++m) { bf16* rowp = H + (size_t)(row0 + ai * 128 + m * 16) * EHID + col0;
                const f32x4 g0 = acc[ai][0][m][0], g1 = acc[ai][0][m][1], u0 = acc[ai][1][m][0], u1 = acc[ai][1][m][1];
                v4u w; w.x = cvt_pk_bf16(silu_f(g0[0]) * u0[0], silu_f(g0[1]) * u0[1]); w.y = cvt_pk_bf16(silu_f(g0[2]) * u0[2], silu_f(g0[3]) * u0[3]);
                w.z = cvt_pk_bf16(silu_f(g1[0]) * u1[0], silu_f(g1[1]) * u1[1]); w.w = cvt_pk_bf16(silu_f(g1[2]) * u1[2], silu_f(g1[3]) * u1[3]);
                *(v4u*)rowp = w; }
    }
};
struct EpiGU8 {
    static constexpr bool PERM = true;
    unsigned char* H;
    __device__ __forceinline__ void operator()(const f32x4 (&acc)[2][2][4][2], const UnitP& u, int wr, int wc, int fr, int fq) const {
        const int row0 = u.row0 + wr * 64 + fr, col0 = u.col0 + wc * 32 + 8 * fq;
#pragma unroll
        for (int ai = 0; ai < 2; ++ai)
#pragma unroll
            for (int m = 0; m < 4; ++m) { unsigned char* rowp = H + (size_t)(row0 + ai * 128 + m * 16) * EHID + col0;
                constexpr float ws = F8_UNSCALED ? (1.0f / 64.0f) : 1.0f;
                const f32x4 g0 = acc[ai][0][m][0] * ws, g1 = acc[ai][0][m][1] * ws, u0 = acc[ai][1][m][0] * ws, u1 = acc[ai][1][m][1] * ws;
                v2u w; w.x = pk4_fp8(silu_f(g0[0]) * u0[0], silu_f(g0[1]) * u0[1], silu_f(g0[2]) * u0[2], silu_f(g0[3]) * u0[3]);
                w.y = pk4_fp8(silu_f(g1[0]) * u1[0], silu_f(g1[1]) * u1[1], silu_f(g1[2]) * u1[2], silu_f(g1[3]) * u1[3]);
                if (H != nullptr) *(v2u*)rowp = w; else asm volatile("" :: "v"(w.x), "v"(w.y)); }
    }
};
constexpr float YM_SCALE = 8.0f;
struct EpiDown {
    static constexpr bool PERM = true;
    bf16* O;
    __device__ __forceinline__ void operator()(const f32x4 (&acc)[2][2][4][2], const UnitP& u, int wr, int wc, int fr, int fq) const {
        const int row0 = u.row0 + wr * 64 + fr, col0 = u.col0 + wc * 32 + 8 * fq;
#pragma unroll
        for (int ai = 0; ai < 2; ++ai)
#pragma unroll
            for (int m = 0; m < 4; ++m) {
#if MOE_F8
                unsigned char* rowp = (unsigned char*)O + (size_t)(row0 + ai * 128 + m * 16) * DM + col0;
#pragma unroll
                for (int bj = 0; bj < 2; ++bj) { constexpr float ys = F8_UNSCALED ? YM_SCALE / 64.0f : YM_SCALE; const f32x4 v0 = acc[ai][bj][m][0] * ys, v1 = acc[ai][bj][m][1] * ys;
                    v2u w; w.x = pk4_fp8(v0[0], v0[1], v0[2], v0[3]); w.y = pk4_fp8(v1[0], v1[1], v1[2], v1[3]); *(v2u*)(rowp + bj * 128) = w; }
#else
                bf16* rowp = O + (size_t)(row0 + ai * 128 + m * 16) * DM + col0;
#pragma unroll
                for (int bj = 0; bj < 2; ++bj) { const f32x4 v0 = acc[ai][bj][m][0], v1 = acc[ai][bj][m][1];
                    v4u w; w.x = cvt_pk_bf16(v0[0], v0[1]); w.y = cvt_pk_bf16(v0[2], v0[3]); w.z = cvt_pk_bf16(v1[0], v1[1]); w.w = cvt_pk_bf16(v1[2], v1[3]);
                    *(v4u*)(rowp + bj * 128) = w; }
#endif
            }
    }
};

__device__ __forceinline__ void moe_tables(Frame& F) {
    LAS int* ts = (LAS int*)(F.lds + TAB_OFF); LAS int* cn = ts + 40;
    __syncthreads();
    if (F.tid < NEXP) cn[F.tid] = (int)__hip_atomic_load(F.ctl + CW_CNT + 64 * F.tid, RLX_AGENT);
    __syncthreads();
    if (F.tid == 0) { int a = 0; for (int e = 0; e < NEXP; ++e) { ts[e] = a; a += (cn[e] + 255) >> 8; } ts[NEXP] = a; }
    __syncthreads();
}
__device__ __forceinline__ bool moe_locate(LAS const int* ts, int rt, int& e, int& first, int& cnt) {
    const int ln = (int)(threadIdx.x & 63u), l31 = ln & 31;
    const int te = ts[l31 + 1], tb = ts[l31], cn = ts[40 + l31];
    if (rt >= __builtin_amdgcn_readlane(te, 31)) return false;
    const unsigned long long bal = __ballot(ln < 32 && te <= rt);
    e = (int)__popcll(bal);
    first = __builtin_amdgcn_readlane(tb, e); cnt = __builtin_amdgcn_readlane(cn, e);
    return true;
}
struct GateUpSched {
    static constexpr bool RAGGED = true;
    const char* A; const char* W; const int* LIST; LAS const int* ts; int G, c; unsigned rowb; int wsh;
    __device__ __forceinline__ bool get(int i, UnitP& u, const int (&R)[2], const int (&C)[2]) const {
        const int L = i * G + c, rt = L >> 3, pn = L & 7;
        int e, first, cnt; if (!moe_locate(ts, rt, e, first, cnt)) return false;
        const int j = rt - first, nvalid = cnt - j * 256;
#pragma unroll
        for (int h = 0; h < 2; ++h)
#pragma unroll
            for (int i2 = 0; i2 < 2; ++i2) { const int r = h * 128 + R[i2]; int tok = 0; if (r < nvalid) tok = LIST[(size_t)e * 32768 + j * 256 + r]; u.ao[h][i2] = (unsigned)tok * rowb + (unsigned)C[i2] * 2u; }
        u.A = A; u.B = W + ((size_t)(e * 8 + pn) << wsh); u.row0 = rt * 256; u.col0 = pn * 128; u.aux = e; u.vr = nvalid;
        return true;
    }
};
struct DownSched {
    static constexpr bool RAGGED = true;
    const char* A; const char* W; LAS const int* ts; int G, c; unsigned rowb; int wsh;
    __device__ __forceinline__ bool get(int i, UnitP& u, const int (&R)[2], const int (&C)[2]) const {
        const int L = i * G + c, rt = L >> 3, pn = L & 7;
        int e, first, cnt; if (!moe_locate(ts, rt, e, first, cnt)) return false;
#pragma unroll
        for (int h = 0; h < 2; ++h)
#pragma unroll
            for (int i2 = 0; i2 < 2; ++i2) u.ao[h][i2] = (unsigned)(h * 128 + R[i2]) * rowb + (unsigned)C[i2] * 2u;
        u.A = A + (size_t)rt * 256 * rowb; u.B = W + ((size_t)(e * 8 + pn) << wsh); u.row0 = rt * 256; u.col0 = pn * 256; u.aux = e;
        u.vr = cnt - (rt - first) * 256;
        return true;
    }
};

__device__ __forceinline__ void ln1_router(Frame& F, int cw_cnt = CW_CNT, size_t list_off = WS_LIST, size_t rt_off = WS_RT) {
    LAS unsigned char* lds = F.lds + RING_OFF;
    constexpr int WP = 520;
    LAS bf16* wqh = (LAS bf16*)lds;
    LAS bf16* wql = (LAS bf16*)(lds + 48 * WP * 2);
    LAS float* scr = (LAS float*)(lds + 102400 + F.wave * 3200);
    LAS float* gbq = (LAS float*)(F.lds + 135168);
    const bf16* Y = WSP(bf16, WS_Y); const f32x2* STAT = WSP(f32x2, WS_STAT); const bf16* WRH = WSP(bf16, WS_WRT); const bf16* WRL = WRH + 48 * 2048;
    bf16* H1B = WSP(bf16, WS_H1B); int* LIST = WSP(int, list_off); unsigned* RT = WSP(unsigned, rt_off);
    const float* g1 = F.in[14]; const float* b1 = F.in[15];
    const int r = F.lane & 15, kq = F.lane >> 4;
    const int ngrp = T / 16, per_pass = F.G * NWAVES;
    LAS unsigned* lhist = (LAS unsigned*)(F.lds + TAB_OFF + 512); LAS unsigned* lbase = lhist + 32;
    for (int base = 0; base < ngrp; base += per_pass) {
        const int grp = base + F.vcu * NWAVES + F.wave; const bool valid = grp < ngrp;
        const int row = (valid ? grp : 0) * 16 + r;
        float mean, rstd;
        { float s = 0.f, q = 0.f;
#pragma unroll
          for (int i = 0; i < 8; ++i) { const f32x2 v = STAT[(size_t)row * 32 + kq * 8 + i]; s += v.x; q += v.y; }
          s += __shfl_xor(s, 16); s += __shfl_xor(s, 32); q += __shfl_xor(q, 16); q += __shfl_xor(q, 32);
          mean = s * (1.0f / DM); const float var = q * (1.0f / DM) - mean * mean; rstd = 1.0f / __builtin_sqrtf(__builtin_fmaxf(var, 0.f) + LN_EPS); }
        if (valid && kq == 0) WSP(f32x2, WS_MR)[row] = (f32x2){mean, rstd};
        f32x4 acc[3];
#pragma unroll
        for (int i = 0; i < 3; ++i) acc[i] = (f32x4){0.f, 0.f, 0.f, 0.f};
        v4u ybuf[2][8];
        { const bf16* yrow = Y + (size_t)row * DM + 16 * kq;
#pragma unroll
          for (int p = 0; p < 4; ++p) { ybuf[0][2 * p] = *(const v4u*)(yrow + 64 * p); ybuf[0][2 * p + 1] = *(const v4u*)(yrow + 64 * p + 8); } }
        v4u tq[12]; f32x4 gq = {0.f, 0.f, 0.f, 0.f};
        auto tq_load = [&](int q) __attribute__((always_inline)) {
            int tl_ = F.tid; asm volatile("" : "+v"(tl_));
#pragma unroll
            for (int k = 0; k < 12; ++k) { const int f = tl_ + k * (NWAVES * 64); const int hl = f / (48 * 64), rem = f % (48 * 64), col = rem >> 6, k8 = rem & 63;
                tq[k] = *(const v4u*)(WRH + (size_t)hl * 48 * 2048 + (size_t)col * 2048 + q * 512 + 8 * k8); }
            if (F.tid < 256) gq = *(const f32x4*)((F.tid < 128 ? g1 : b1) + q * 512 + (F.tid & 127) * 4);
        };
        auto tq_store = [&]() __attribute__((always_inline)) {
            int tl_ = F.tid; asm volatile("" : "+v"(tl_));
#pragma unroll
            for (int k = 0; k < 12; ++k) { const int f = tl_ + k * (NWAVES * 64); const int hl = f / (48 * 64), rem = f % (48 * 64), col = rem >> 6, k8 = rem & 63;
                *(LAS v4u*)((LAS bf16*)lds + hl * 48 * WP + col * WP + 8 * k8) = tq[k]; }
            if (F.tid < 256) *(LAS f32x4*)(gbq + (F.tid < 128 ? 0 : 512) + (F.tid & 127) * 4) = gq;
        };
        tq_load(0);
#pragma nounroll
        for (int qk = 0; qk < 4; ++qk) {
#pragma unroll
          for (int eh = 0; eh < 2; ++eh) {
            const int e8 = 2 * qk + eh;
            if (e8 < 7) { const bf16* yrow = Y + (size_t)row * DM + (e8 + 1) * 256 + 16 * kq;
#pragma unroll
              for (int p = 0; p < 4; ++p) { ybuf[(eh + 1) & 1][2 * p] = *(const v4u*)(yrow + 64 * p); ybuf[(eh + 1) & 1][2 * p + 1] = *(const v4u*)(yrow + 64 * p + 8); } }
            if (eh == 0) {
                __syncthreads();
                tq_store();
                if (qk < 3) tq_load(qk + 1);
                LDS_WAIT(); __syncthreads();
            }
            if (valid) {
                const int c0 = eh * 256;
                bf16* hrow = H1B + (size_t)row * DM + e8 * 256 + 16 * kq;
                unsigned char* h8row = WSP(unsigned char, WS_H1F8) + (size_t)row * DM + e8 * 256 + 16 * kq;
                LAS const float* gp = gbq + c0 + 16 * kq; LAS const float* bp = gbq + 512 + c0 + 16 * kq;
                LAS const bf16* whr = wqh + r * WP + c0 + 16 * kq; LAS const bf16* wlr = wql + r * WP + c0 + 16 * kq;
#pragma unroll
                for (int p = 0; p < 4; ++p) {
                    v4u hi8[2]; v2u f8[2];
#pragma unroll
                    for (int hf = 0; hf < 2; ++hf) {
                        const v4u yv = ybuf[eh][2 * p + hf];
                        const int co = 64 * p + 8 * hf;
                        const f32x4 y0 = {bflo(yv.x), bfhi(yv.x), bflo(yv.y), bfhi(yv.y)}, y1 = {bflo(yv.z), bfhi(yv.z), bflo(yv.w), bfhi(yv.w)};
                        const f32x4 ga = *(LAS const f32x4*)(gp + co), gb = *(LAS const f32x4*)(gp + co + 4), ba = *(LAS const f32x4*)(bp + co), bb = *(LAS const f32x4*)(bp + co + 4);
                        const f32x4 h0 = (y0 - mean) * rstd * ga + ba, h1 = (y1 - mean) * rstd * gb + bb;
                        v4u hi4, lo4;
                        hi4.x = cvt_pk_bf16(h0.x, h0.y); hi4.y = cvt_pk_bf16(h0.z, h0.w); hi4.z = cvt_pk_bf16(h1.x, h1.y); hi4.w = cvt_pk_bf16(h1.z, h1.w);
                        lo4.x = cvt_pk_bf16(h0.x - bflo(hi4.x), h0.y - bfhi(hi4.x)); lo4.y = cvt_pk_bf16(h0.z - bflo(hi4.y), h0.w - bfhi(hi4.y));
                        lo4.z = cvt_pk_bf16(h1.x - bflo(hi4.z), h1.y - bfhi(hi4.z)); lo4.w = cvt_pk_bf16(h1.z - bflo(hi4.w), h1.w - bfhi(hi4.w));
                        hi8[hf] = hi4;
#if MOE_F8
                        f8[hf].x = pk4_fp8(h0.x, h0.y, h0.z, h0.w); f8[hf].y = pk4_fp8(h1.x, h1.y, h1.z, h1.w);
#endif
                        const bf16x8 ah = __builtin_bit_cast(bf16x8, hi4), al = __builtin_bit_cast(bf16x8, lo4);
#pragma unroll
                        for (int tn = 0; tn < 3; ++tn) {
                            const bf16x8 wh = *(LAS const bf16x8*)(whr + tn * 16 * WP + co), wl = *(LAS const bf16x8*)(wlr + tn * 16 * WP + co);
                            acc[tn] = __builtin_amdgcn_mfma_f32_16x16x32_bf16(ah, wh, acc[tn], 0, 0, 0);
                            acc[tn] = __builtin_amdgcn_mfma_f32_16x16x32_bf16(al, wh, acc[tn], 0, 0, 0);
                            acc[tn] = __builtin_amdgcn_mfma_f32_16x16x32_bf16(ah, wl, acc[tn], 0, 0, 0); }
                    }
#if !MOE_F8
                    *(v4u*)(hrow + 64 * p) = hi8[0]; *(v4u*)(hrow + 64 * p + 8) = hi8[1];
#endif
#if MOE_F8
                    { v4u f16 = {f8[0].x, f8[0].y, f8[1].x, f8[1].y}; *(v4u*)(h8row + 64 * p) = f16; }
#endif
                }
            }
          }
        }
#pragma unroll
        for (int tn = 0; tn < 3; ++tn)
#pragma unroll
            for (int rg = 0; rg < 4; ++rg) scr[(4 * kq + rg) * 49 + 16 * tn + r] = acc[tn][rg];
        LDS_WAIT(); asm volatile("" ::: "memory");
        int e0 = 0, e1 = 0; unsigned lr0 = 0u, lr1 = 0u; float wt0 = 0.f, wt1 = 0.f;
        if (valid && F.lane < 16) {
            LAS const float* lr = scr + F.lane * 49;
            float gl[4]; float gm = -1e30f; int gi = 0;
#pragma unroll
            for (int i = 0; i < 4; ++i) { gl[i] = lr[i] + F.in[17][i]; if (gl[i] > gm) { gm = gl[i]; gi = i; } }
            float gs = 0.f;
#pragma unroll
            for (int i = 0; i < 4; ++i) gs += __expf(gl[i] - gm);
            const float gprob = 1.0f / gs;
            float el[8];
#pragma unroll
            for (int i = 0; i < 8; ++i) el[i] = lr[4 + 8 * gi + i] + F.in[19][gi * 8 + i];
            float m1 = -1e30f; int i1 = 0;
#pragma unroll
            for (int i = 0; i < 8; ++i) if (el[i] > m1) { m1 = el[i]; i1 = i; }
            float m2 = -1e30f; int i2 = 0;
#pragma unroll
            for (int i = 0; i < 8; ++i) if (i != i1 && el[i] > m2) { m2 = el[i]; i2 = i; }
            const float e2 = __expf(m2 - m1); const float w0 = gprob / (1.0f + e2), w1 = gprob * e2 / (1.0f + e2);
            e0 = gi * 8 + i1; e1 = gi * 8 + i2; wt0 = w0; wt1 = w1;
            lr0 = __hip_atomic_fetch_add(lhist + e0, 1u, __ATOMIC_RELAXED, __HIP_MEMORY_SCOPE_WORKGROUP);
            lr1 = __hip_atomic_fetch_add(lhist + e1, 1u, __ATOMIC_RELAXED, __HIP_MEMORY_SCOPE_WORKGROUP);
        }
        LDS_WAIT(); __syncthreads();
        if (F.tid < NEXP) { const unsigned c = lhist[F.tid]; unsigned gb = 0u; if (c) gb = __hip_atomic_fetch_add(F.ctl + cw_cnt + 64 * F.tid, c, RLX_AGENT);
            lbase[F.tid] = gb; lhist[F.tid] = 0u; }
        LDS_WAIT(); __syncthreads();
        if (valid && F.lane < 16) {
            const int tok = grp * 16 + F.lane;
            const unsigned r0 = lbase[e0] + lr0, r1 = lbase[e1] + lr1;
            LIST[(size_t)e0 * 32768 + r0] = tok; LIST[(size_t)e1 * 32768 + r1] = tok;
            v4u rec = {(unsigned)e0, r0, (unsigned)e1, r1}; *(v4u*)(RT + (size_t)tok * 8) = rec;
            v2u wr2 = {__float_as_uint(wt0), __float_as_uint(wt1)}; *(v2u*)(RT + (size_t)tok * 8 + 4) = wr2;
        }
    }
    __syncthreads();
}

struct FinRow { v4u hh[4]; v2u ya[4], yb[4]; float w0, w1; f32x2 mr; };
__device__ __forceinline__ void fin_issue(FinRow& R, const bf16* H1B, const f32x2* MR, const unsigned char* YM, LAS const int* ts, int row, const v4u& rec, const v2u& wr2, int lane) {
    const size_t s0 = (size_t)ts[rec.x & 31] * 256 + rec.y, s1 = (size_t)ts[rec.z & 31] * 256 + rec.w;
    R.w0 = __uint_as_float(wr2.x); R.w1 = __uint_as_float(wr2.y); R.mr = MR[row];
#pragma unroll
    for (int j = 0; j < 4; ++j) { const int c = 512 * j + 8 * lane;
        R.hh[j] = *(const v4u*)(H1B + (size_t)row * DM + c);
#if MOE_F8
        R.ya[j] = *(const v2u*)(YM + s0 * DM + c); R.yb[j] = *(const v2u*)(YM + s1 * DM + c);
#endif
    }
}
__device__ __forceinline__ void fin_reduce(const FinRow& R, float* out, LAS const float* gl, int row, int lane_in) {
    int lane = lane_in; asm volatile("" : "+v"(lane));
    typedef float f2 __attribute__((ext_vector_type(2)));
    float v[4][8]; float sum = 0.f;
    const float w0 = R.w0 * (1.0f / YM_SCALE), w1 = R.w1 * (1.0f / YM_SCALE);
#pragma unroll
    for (int j = 0; j < 4; ++j) {
        const int c8 = 512 * j + 8 * lane;
        const int p0 = ((2 * j) * 64 + lane) * 4, p1 = ((2 * j + 1) * 64 + lane) * 4;
        const f32x4 ga = *(LAS const f32x4*)(gl + p0), gb = *(LAS const f32x4*)(gl + p1), ba = *(LAS const f32x4*)(gl + 2048 + p0), bb = *(LAS const f32x4*)(gl + 2048 + p1);
        const float g1v[8] = {ga.x, ga.y, ga.z, ga.w, gb.x, gb.y, gb.z, gb.w}, b1v[8] = {ba.x, ba.y, ba.z, ba.w, bb.x, bb.y, bb.z, bb.w};
#pragma unroll
        for (int i = 0; i < 4; ++i) {
            const unsigned aw = (i < 2) ? R.ya[j].x : R.ya[j].y, bw = (i < 2) ? R.yb[j].x : R.yb[j].y;
            const f2 fa = (i & 1) ? __builtin_amdgcn_cvt_pk_f32_fp8((int)aw, true) : __builtin_amdgcn_cvt_pk_f32_fp8((int)aw, false);
            const f2 fb = (i & 1) ? __builtin_amdgcn_cvt_pk_f32_fp8((int)bw, true) : __builtin_amdgcn_cvt_pk_f32_fp8((int)bw, false);
            const float h1a = (bflo(R.hh[j][i]) - R.mr.x) * R.mr.y * g1v[2 * i] + b1v[2 * i], h1b = (bfhi(R.hh[j][i]) - R.mr.x) * R.mr.y * g1v[2 * i + 1] + b1v[2 * i + 1];
            v[j][2 * i] = DN_ALPHA * h1a + w0 * fa.x + w1 * fb.x;
            v[j][2 * i + 1] = DN_ALPHA * h1b + w0 * fa.y + w1 * fb.y;
            sum += v[j][2 * i] + v[j][2 * i + 1]; }
    }
    const float mean = wave_sum(sum) * (1.0f / DM); float sq = 0.f;
#pragma unroll
    for (int j = 0; j < 4; ++j)
#pragma unroll
        for (int i = 0; i < 8; ++i) { v[j][i] -= mean; sq += v[j][i] * v[j][i]; }
    const float rstd = 1.0f / __builtin_sqrtf(wave_sum(sq) * (1.0f / DM) + LN_EPS);
#pragma unroll
    for (int j = 0; j < 4; ++j) {
        const int c = 512 * j + 8 * lane;
#pragma unroll
        for (int hq = 0; hq < 2; ++hq) { const int pq = ((2 * j + hq) * 64 + lane) * 4; const f32x4 gg = *(LAS const f32x4*)(gl + 4096 + pq), bb = *(LAS const f32x4*)(gl + 6144 + pq);
            f32x4 o; o.x = v[j][4 * hq] * rstd * gg.x + bb.x; o.y = v[j][4 * hq + 1] * rstd * gg.y + bb.y; o.z = v[j][4 * hq + 2] * rstd * gg.z + bb.z; o.w = v[j][4 * hq + 3] * rstd * gg.w + bb.w;
            *(f32x4*)(out + (size_t)row * DM + c + 4 * hq) = o; }
    }
}
__device__ __forceinline__ void final_ln(Frame& F) {
    moe_tables(F);
    LAS const int* ts = (LAS const int*)(F.lds + TAB_OFF);
    static_assert(MOE_F8, "the final phase rebuilds h1 from the pre-LN1 rows (fp8 MoE build)");
    const bf16* H1B = WSP(bf16, WS_Y); const f32x2* MR = WSP(f32x2, WS_MR); const unsigned char* YM = WSP(unsigned char, WS_YMOE); const unsigned* RT = WSP(unsigned, WS_RT);
    LAS float* gl = (LAS float*)(F.lds + RING_OFF);
    for (int i = F.tid; i < 2048; i += NWAVES * 64) { const int d = (((i >> 9) * 2 + ((i >> 2) & 1)) * 64 + ((i >> 3) & 63)) * 4 + (i & 3);
        gl[d] = F.in[14][i]; gl[2048 + d] = F.in[15][i]; gl[4096 + d] = F.in[23][i]; gl[6144 + d] = F.in[24][i]; }
    LDS_WAIT(); __syncthreads();
    const int step = F.G * NWAVES; int row = F.vcu * NWAVES + F.wave;
    if (row >= T) return;
    FinRow RA, RB;
    v4u rec = *(const v4u*)(RT + (size_t)row * 8); v2u wr2 = *(const v2u*)(RT + (size_t)row * 8 + 4);
    fin_issue(RA, H1B, MR, YM, ts, row, rec, wr2, F.lane);
    { const int rn = row + step < T ? row + step : row; rec = *(const v4u*)(RT + (size_t)rn * 8); wr2 = *(const v2u*)(RT + (size_t)rn * 8 + 4); }
    for (;;) {
        const int r1 = row + step; const bool h1 = r1 < T;
        if (h1) fin_issue(RB, H1B, MR, YM, ts, r1, rec, wr2, F.lane);
        { const int rn = r1 + step < T ? r1 + step : row; rec = *(const v4u*)(RT + (size_t)rn * 8); wr2 = *(const v2u*)(RT + (size_t)rn * 8 + 4); }
        fin_reduce(RA, F.out, gl, row, F.lane);
        if (!h1) break;
        const int r2 = r1 + step; const bool h2 = r2 < T;
        if (h2) fin_issue(RA, H1B, MR, YM, ts, r2, rec, wr2, F.lane);
        { const int rn = r2 + step < T ? r2 + step : row; rec = *(const v4u*)(RT + (size_t)rn * 8); wr2 = *(const v2u*)(RT + (size_t)rn * 8 + 4); }
        fin_reduce(RB, F.out, gl, r1, F.lane);
        if (!h2) break;
        row = r2;
    }
}
#ifndef MK_SPLIT
#define MK_SPLIT 0
#endif
constexpr int N_PHASES = 10;
#ifndef MOE_ALIGN
#define MOE_ALIGN true
#endif
#ifndef GEMM_ALIGN
#define GEMM_ALIGN true
#endif
#ifndef ATT_PROBE_MODE
#define ATT_PROBE_MODE 0
#endif
#ifndef SSDC_EARLY
#define SSDC_EARLY 1
#endif
#ifndef SB_MASK
#define SB_MASK CVT_MASK
#endif
#ifndef P7_PROBE
#define P7_PROBE 0
#endif
#ifndef GEMM_PROBE_Q
#define GEMM_PROBE_Q 0
#endif
#ifndef REP_PHASE
#define REP_PHASE -1
#endif
__device__ __forceinline__ void fresh_ids(Frame& F) { int l = (int)__builtin_amdgcn_mbcnt_hi(~0u, __builtin_amdgcn_mbcnt_lo(~0u, 0u)); asm volatile("" : "+v"(l)); F.lane = l; F.tid = F.wave * 64 + l; }
__device__ __forceinline__ void phase0(Frame& F) { p0_prologue(F); }
__device__ __forceinline__ void phase1(Frame& F) {
    pg8::DenseSched S; S.init(WSP(bf16, WS_XB), WSP(bf16, WS_WIN), T, PITCH, DM, F.G, (int)blockIdx.x);
    EpiProj E{WSP(bf16, WS_PROJ), WSP(float, WS_NRM), (LAS float*)(F.lds + 135168)};
    static_assert(GEMM_ALIGN, "EpiProj's norm exchange has a workgroup barrier");
    pg8::gemm_phase<EpiProj, pg8::DenseSched, GEMM_ALIGN>(F.lds + RING_OFF, DM, S, E);
}
__device__ __forceinline__ void phase2(Frame& F) {
#ifdef NRM_CHECK
    att::att_norms<true>(F);
#endif
    for (int u = F.vcu; u < NB * 128 * 2; u += F.G) ssd::ssd_a_unit(F, u >> 8, (u >> 1) & 127, u & 1);
}
__device__ __forceinline__ void phase3(Frame& F, int rep = 0) {
    if (rep == 0 && (F.vcu & SB_MASK) == 0) ssd::ssd_b_queue(F);
    if (rep == 0 && (F.vcu & CVT_MASK) == 0) {
#if MOE_DEFER
        moe_convert(F);
#endif
        if (SSDC_EARLY) ssd::ssd_c_queue(F);
    }
    float lam;
    { const float s1 = wave_sum(F.in[2][F.lane] * F.in[3][F.lane]), s2 = wave_sum(F.in[4][F.lane] * F.in[5][F.lane]); lam = __expf(s1) - __expf(s2) + 0.2f; }
    volatile LAS unsigned* qslot = F.MISC + 16;
    const int myx = (int)(xb_xcc_id() & 7u);
    int sx = 0;
    __syncthreads();
    if (F.tid == 0) *qslot = __hip_atomic_fetch_add(F.ctl + CW_ATTQ + 64 * myx + 1024 * rep, 1u, RLX_AGENT);
    for (;;) {
        __syncthreads();
        const unsigned u = (unsigned)__builtin_amdgcn_readfirstlane((int)*qslot);
        const int x = (myx + sx) & 7;
        if (u >= 256u) {
            if (++sx == 8) break;
            __syncthreads();
            if (F.tid == 0) *qslot = __hip_atomic_fetch_add(F.ctl + CW_ATTQ + 64 * ((myx + sx) & 7) + 1024 * rep, 1u, RLX_AGENT);
            continue;
        }
        unsigned nxt = 0u;
        if (F.tid == 0) nxt = __hip_atomic_fetch_add(F.ctl + CW_ATTQ + 64 * x + 1024 * rep, 1u, RLX_AGENT);
        int hb[4]; { const int h0 = x, h1 = 7 - x, h2 = (x + 4) & 7, h3 = 7 - ((x + 4) & 7);
            hb[0] = h0 * 4 + 0; hb[1] = h1 * 4 + 1; hb[2] = h2 * 4 + 2; hb[3] = h3 * 4 + 3;
#pragma unroll
            for (int a = 0; a < 3; ++a)
#pragma unroll
                for (int c = 0; c < 3 - a; ++c) if (hb[c] < hb[c + 1]) { const int t_ = hb[c]; hb[c] = hb[c + 1]; hb[c + 1] = t_; } }
        const int pi = (int)(u >> 6), qb = 63 - (int)(u & 63u);
        const int key = __builtin_amdgcn_readfirstlane((pi == 0) ? hb[0] : (pi == 1) ? hb[1] : (pi == 2) ? hb[2] : hb[3]);
        if (rep == 0) att::attn_unit<0>(F, key & 3, key >> 2, qb, lam);
        else if (ATT_PROBE_MODE == 20) { if ((F.vcu & 3) == 0 && (u & 3u) == 0u) att::attn_unit<0>(F, key & 3, key >> 2, qb, lam); else __syncthreads(); }
        else att::attn_unit<(ATT_PROBE_MODE == 20 ? 0 : ATT_PROBE_MODE)>(F, key & 3, key >> 2, qb, lam);
        if (F.tid == 0) *qslot = nxt;
    }
    if (rep == 0) { ssd::ssd_b_queue(F);
#if MOE_DEFER
        moe_convert(F);
#endif
        ssd::ssd_c_queue(F);
    }
}
__device__ __forceinline__ void phase4(Frame& F) { (void)F; }
__device__ __forceinline__ void phase5(Frame& F) {
    pg8::DenseSched S; S.init(WSP(bf16, WS_XB), WSP(bf16, WS_WOUT), T, DM, DM, F.G, (int)blockIdx.x);
    EpiRes E{F.in[0], WSP(bf16, WS_Y), WSP(f32x2, WS_STAT)};
    pg8::gemm_phase<EpiRes, pg8::DenseSched, GEMM_ALIGN>(F.lds + RING_OFF, DM, S, E);
}
__device__ __forceinline__ void phase6(Frame& F) { ln1_router(F); }
__device__ __forceinline__ void phase7(Frame& F, int probe = 0) {
    moe_tables(F);
#if MOE_F8
    GateUpSched S{(const char*)WSP(unsigned char, WS_H1F8), (const char*)WSP(unsigned char, WS_WGU), WSP(int, WS_LIST), (LAS const int*)(F.lds + TAB_OFF), F.G, F.vcu, 2048u, 19};
    EpiGU8 E{probe == 3 ? (unsigned char*)nullptr : probe ? WSP(unsigned char, WS_XB) : WSP(unsigned char, WS_HID)};
    pg8::gemm_phase<EpiGU8, GateUpSched, MOE_ALIGN, true, 121>(F.lds + RING_OFF, probe == 2 ? DM / 4 : DM / 2, S, E);
#else
    GateUpSched S{(const char*)WSP(bf16, WS_H1B), (const char*)WSP(bf16, WS_WGU), WSP(int, WS_LIST), (LAS const int*)(F.lds + TAB_OFF), F.G, F.vcu, 4096u, 20};
    EpiGU E{WSP(bf16, WS_HID)};
    pg8::gemm_phase<EpiGU, GateUpSched, true>(F.lds + RING_OFF, DM, S, E);
#endif
}
__device__ __forceinline__ void phase8(Frame& F) {
    moe_tables(F);
#if MOE_F8
    DownSched S{(const char*)WSP(unsigned char, WS_HID), (const char*)WSP(unsigned char, WS_WDN), (LAS const int*)(F.lds + TAB_OFF), F.G, F.vcu, 1024u, 18};
    EpiDown E{WSP(bf16, WS_YMOE)};
    pg8::gemm_phase<EpiDown, DownSched, MOE_ALIGN, true, 121>(F.lds + RING_OFF, EHID / 2, S, E);
#else
    DownSched S{(const char*)WSP(bf16, WS_HID), (const char*)WSP(bf16, WS_WDN), (LAS const int*)(F.lds + TAB_OFF), F.G, F.vcu, 2048u, 19};
    EpiDown E{WSP(bf16, WS_YMOE)};
    pg8::gemm_phase<EpiDown, DownSched, true>(F.lds + RING_OFF, EHID, S, E);
#endif
}
__device__ __forceinline__ void phase9(Frame& F) { final_ln(F); }
struct Args { const float* in[25]; float* out; unsigned char* ws; int ph_lo, ph_hi, li, pad; };
__global__ void __launch_bounds__(NWAVES * 64, 2) fwd_kernel(Args args) {
    extern __shared__ __attribute__((aligned(16))) unsigned char lds_raw[];
    Frame F;
    F.lds = (LAS unsigned char*)lds_raw;
    F.MISC = (volatile LAS unsigned*)(F.lds + MISC_OFF);
    F.tid = threadIdx.x; F.lane = F.tid & 63; F.wave = __builtin_amdgcn_readfirstlane(F.tid >> 6);
    F.G = gridDim.x; { const int bx = blockIdx.x; F.vcu = (F.G % 8 == 0) ? (bx % 8) * (F.G / 8) + bx / 8 : bx; }
    F.ws = args.ws; F.out = args.out; F.ctl = (gu32*)(args.ws + WS_CTL);
#pragma unroll
    for (int i = 0; i < 25; ++i) F.in[i] = args.in[i];
    for (int u = F.tid; u < (LDS_BYTES - LDSCTL_OFF) / 4; u += NWAVES * 64) ((LAS unsigned*)(F.lds + LDSCTL_OFF))[u] = 0u;
    __syncthreads();
    XcdBarrier bar = xcd_barrier_post((unsigned*)(F.ctl + CW_BAR) + args.li * XCD_BAR_WORDS, F.MISC + 8);
    const int lo = args.ph_lo, hi = args.ph_hi;
#ifdef ONLY_PHASE
#define IN(k) ((k) == ONLY_PHASE && lo <= (k) && (k) < hi)
#else
#define IN(k) (lo <= (k) && (k) < hi)
#endif
#define SEAM(k) do { if (IN(k) && IN((k) + 1)) xcd_barrier(bar); } while (0)

    if (IN(0)) { phase0(F); if (REP_PHASE == 0) { __syncthreads(); phase0(F); } }
    SEAM(0);
    if (IN(1)) { phase1(F); if (REP_PHASE == 1) { if (!GEMM_PROBE_Q || (F.vcu & 3) == 0) phase1(F); } }
    SEAM(1);
    if (IN(2)) { phase2(F); if (REP_PHASE == 2) phase2(F); }
    SEAM(2);
    if (IN(3)) { phase3(F); if (REP_PHASE == 3) phase3(F, 1); }
    SEAM(4);
    if (IN(5)) { phase5(F); if (REP_PHASE == 5) phase5(F); }
    SEAM(5);
    if (IN(6)) { if (REP_PHASE == 6) ln1_router(F, CW_CNT + 4096, WS_HID, WS_HID + 8 * MiB); phase6(F); }
    SEAM(6);
    if (IN(7)) { phase7(F); if (REP_PHASE == 7) { if (!GEMM_PROBE_Q || (F.vcu & 3) == 0) phase7(F, P7_PROBE); } }
    SEAM(7);
    if (IN(8)) { phase8(F); if (REP_PHASE == 8) { if (!GEMM_PROBE_Q || (F.vcu & 3) == 0) phase8(F); } }
    SEAM(8);
    if (IN(9)) { phase9(F); if (REP_PHASE == 9) phase9(F); }
#ifdef NRM_CHECK
    __syncthreads();
    if (__hip_atomic_load(F.ctl + CW_CODE, RLX_AGENT) != 0u) { for (int i = F.tid; i < 4096; i += NWAVES * 64) F.out[(size_t)F.vcu * 4096 + i] = 1000.0f; }
#endif
#undef IN
#undef SEAM
}

extern "C" void kernel_launch(void* const* d_in, const int* in_sizes, int n_in, void* d_out, int out_size, void* d_ws, size_t ws_size, hipStream_t stream) {
    static int grid = 0;
    if (grid == 0) {
        if (n_in != 25 || out_size != T * DM || ws_size < WS_END) { fprintf(stderr, "kernel_launch: unexpected problem shape (n_in %d out %d ws %zu)\n", n_in, out_size, ws_size); grid = -1; return; }
        int dev = 0, cus = 0, per_cu = 0;
        if (hipGetDevice(&dev) != hipSuccess || hipDeviceGetAttribute(&cus, hipDeviceAttributeMultiprocessorCount, dev) != hipSuccess) { grid = -1; return; }
        if (hipFuncSetAttribute((const void*)fwd_kernel, hipFuncAttributeMaxDynamicSharedMemorySize, LDS_BYTES) != hipSuccess) { fprintf(stderr, "kernel_launch: hipFuncSetAttribute failed\n"); grid = -1; return; }
        if (hipOccupancyMaxActiveBlocksPerMultiprocessor(&per_cu, (const void*)fwd_kernel, NWAVES * 64, LDS_BYTES) != hipSuccess || per_cu < 1) fprintf(stderr, "kernel_launch: occupancy query reports %d\n", per_cu);
        (void)hipGetLastError();
        grid = cus;
    }
    if (grid < 0) return;
    if (hipMemsetAsync((char*)d_ws + WS_CTL, 0, CTL_ZERO_BYTES, stream) != hipSuccess) return;
    Args a{};
    for (int i = 0; i < 25; ++i) a.in[i] = (const float*)d_in[i];
    a.out = (float*)d_out; a.ws = (unsigned char*)d_ws; a.pad = 0;
#if MK_SPLIT
    for (int li = 0; li < N_PHASES; ++li) { a.ph_lo = li; a.ph_hi = li + 1; a.li = li; hipLaunchKernelGGL(fwd_kernel, dim3(grid), dim3(NWAVES * 64), LDS_BYTES, stream, a); }
#else
    a.ph_lo = 0; a.ph_hi = N_PHASES; a.li = 0;
    hipLaunchKernelGGL(fwd_kernel, dim3(grid), dim3(NWAVES * 64), LDS_BYTES, stream, a);
#endif
}
```
